# Optimizing an MI355X kernel written in HIP

```python
import math
import jax, jax.numpy as jnp
from jax import lax
import numpy as np


D_MODEL = 2048
BATCH = 16
SEQ = 2048
DEPTH = 4

GRID_W = 64
CTX_LEN = 256
N_MIXERS = 3
Q_BLOCK = 128
ROPE_THETA = 10000.0
NORM_EPS = 1e-6

D_FF = 4 * D_MODEL

MLA_NOPE = 128
MLA_ROPE = 64
MLA_V = 128
MLA_HEADS = D_MODEL // 128
MLA_Q_RANK = 768
MLA_KV_RANK = 512

HY_SHORT = 3
HY_EMB_DIM = 33
HY_FILT_ORDER = 64
HY_TARGET = 1e-2
HY_FAST_PCT = 0.3
HY_SLOW_PCT = 1.5

DF_HEAD_DIM = 128
DF_HEADS = D_MODEL // (2 * DF_HEAD_DIM)
DF_SUBLN_EPS = 1e-5

N_LAYERS_A = (DEPTH + N_MIXERS - 1) // N_MIXERS
N_LAYERS_B = (DEPTH + N_MIXERS - 2) // N_MIXERS
N_LAYERS_C = (DEPTH + N_MIXERS - 3) // N_MIXERS

kernel_name = 'hybrid_mla_hyena_diffattn_dit'


def rmsnorm(x, g, eps=NORM_EPS):
    xf = x.astype(jnp.float32)
    y = xf * lax.rsqrt(jnp.mean(xf * xf, axis=-1, keepdims=True) + eps)
    return (y * g.astype(jnp.float32)).astype(x.dtype)


def modulate(x, shift, scale):
    return x * (1 + scale) + shift


def axial_rope_tables(L, rot_dim):
    rows = L // GRID_W
    row = jnp.repeat(jnp.arange(rows, dtype=jnp.float32), GRID_W)
    col = jnp.tile(jnp.arange(GRID_W, dtype=jnp.float32), rows)
    pos = jnp.stack([row, col], axis=-1)
    n_freq = rot_dim // 4
    inv_freq = ROPE_THETA ** (-jnp.arange(n_freq, dtype=jnp.float32) / n_freq)
    ang = pos[:, :, None, None] * inv_freq
    ang = jnp.broadcast_to(ang, (L, 2, 2, n_freq)).reshape(L, rot_dim)
    return jnp.cos(ang), jnp.sin(ang)


def apply_axial_rope(x, cos, sin):
    R = x.shape[-1]
    bshape = (cos.shape[0],) + (1,) * (x.ndim - 3) + (R,)
    cos = cos.reshape(bshape).astype(x.dtype)
    sin = sin.reshape(bshape).astype(x.dtype)
    xs = x.reshape(*x.shape[:-1], 2, 2, R // 4)
    rot = jnp.stack([-xs[..., 1, :], xs[..., 0, :]], axis=-2).reshape(x.shape)
    return x * cos + rot * sin


def attend(q, k, v, scale):
    s = jnp.einsum('bqhd,bshd->bhqs', q, k).astype(jnp.float32) * scale
    p = jax.nn.softmax(s, axis=-1).astype(v.dtype)
    return jnp.einsum('bhqs,bshd->bqhd', p, v)


def diff_attend(q, k, v, lam, scale):
    s = jnp.einsum('bqhcd,bshcd->bhcqs', q, k).astype(jnp.float32) * scale
    p = jax.nn.softmax(s, axis=-1)
    a = p[:, :, 0] - lam * p[:, :, 1]
    return jnp.einsum('bhqs,bshd->bqhd', a.astype(v.dtype), v)


def sweep_query_blocks(block_fn, *qs):
    B, L = qs[0].shape[:2]
    nb = L // Q_BLOCK
    blocks = tuple(jnp.moveaxis(q.reshape(B, nb, Q_BLOCK, *q.shape[2:]), 1, 0) for q in qs)
    out = lax.map(lambda qb: block_fn(*qb), blocks)
    return jnp.moveaxis(out, 0, 1).reshape(B, L, *out.shape[3:])


def mla_mixer(uc, ul, w_dq, q_norm_g, w_uq, w_dkv, kv_norm_g, w_ukv, w_o, cos, sin, need_ctx):
    B, C, _ = uc.shape
    L = ul.shape[1]
    S = C + L
    u = jnp.concatenate([uc, ul], axis=1)
    ckv_full = u @ w_dkv
    ckv = rmsnorm(ckv_full[..., :MLA_KV_RANK], kv_norm_g)
    kv = (ckv @ w_ukv).reshape(B, S, MLA_HEADS, MLA_NOPE + MLA_V)
    k_nope, v = kv[..., :MLA_NOPE], kv[..., MLA_NOPE:]
    k_rope = ckv_full[..., None, MLA_KV_RANK:]
    k_rope = jnp.concatenate([k_rope[:, :C], apply_axial_rope(k_rope[:, C:], cos, sin)], axis=1)
    k = jnp.concatenate([k_nope, jnp.broadcast_to(k_rope, (B, S, MLA_HEADS, MLA_ROPE))], axis=-1)
    scale = (MLA_NOPE + MLA_ROPE) ** -0.5

    def queries(us):
        q = rmsnorm(us @ w_dq, q_norm_g) @ w_uq
        return q.reshape(B, us.shape[1], MLA_HEADS, MLA_NOPE + MLA_ROPE)

    ql = queries(ul)
    ql = jnp.concatenate([ql[..., :MLA_NOPE], apply_axial_rope(ql[..., MLA_NOPE:], cos, sin)], axis=-1)
    ol = sweep_query_blocks(lambda qb: attend(qb, k, v, scale), ql)
    yl = ol.reshape(B, L, MLA_HEADS * MLA_V) @ w_o
    if not need_ctx:
        return None, yl
    oc = attend(queries(uc), k[:, :C], v[:, :C], scale)
    return oc.reshape(B, C, MLA_HEADS * MLA_V) @ w_o, yl


def short_conv(u, w, b):
    L = u.shape[1]
    pad = HY_SHORT // 2
    up = jnp.pad(u, ((0, 0), (pad, pad), (0, 0)))
    return sum(up[:, j:j + L] * w[j] for j in range(HY_SHORT)) + b


def hyena_filters(L, w1, b1, w2, b2, w3, b3, freq, w_out):
    t = jnp.linspace(0.0, 1.0, L, dtype=jnp.float32)[:, None]
    bands = (HY_EMB_DIM - 1) // 2
    w = 2.0 * math.pi * jnp.arange(L, dtype=jnp.float32)[:, None] / L
    f = jnp.linspace(1e-4, bands - 1, bands, dtype=jnp.float32)
    feats = jnp.concatenate([t, jnp.cos(f * w), -jnp.sin(f * w)], axis=-1)
    h = jnp.sin(freq[0] * (feats @ w1 + b1))
    h = jnp.sin(freq[1] * (h @ w2 + b2))
    h = jnp.sin(freq[2] * (h @ w3 + b3))
    h = (h @ w_out).astype(jnp.float32)
    deltas = jnp.abs(jnp.linspace(math.log(HY_TARGET) / HY_SLOW_PCT, math.log(HY_TARGET) / HY_FAST_PCT,
                                  D_MODEL, dtype=jnp.float32))
    decay = jnp.exp(-t * deltas)
    return h[:, :D_MODEL] * decay, h[:, D_MODEL:] * decay


def bidir_long_conv(u, h_fwd, h_bwd):
    L = u.shape[1]
    n = 2 * L
    k = jnp.concatenate([h_fwd, jnp.zeros_like(h_fwd[:1]), h_bwd[:0:-1]], axis=0)
    kf = jnp.fft.rfft(k, n=n, axis=0)
    uf = jnp.fft.rfft(u.astype(jnp.float32), n=n, axis=1)
    y = jnp.fft.irfft(uf * kf, n=n, axis=1)[:, :L]
    return y.astype(u.dtype)


def hyena_mixer(uc, ul, w_in, b_in, conv_w, conv_b, f_w1, f_b1, f_w2, f_b2, f_w3, f_b3, f_freq, f_wout,
                f_bias, w_out, b_out, need_ctx):
    def operator(u):
        L = u.shape[1]
        z = short_conv(u @ w_in + b_in, conv_w, conv_b)
        x0, x1, v = jnp.split(z, 3, axis=-1)
        h_f, h_b = hyena_filters(L, f_w1, f_b1, f_w2, f_b2, f_w3, f_b3, f_freq, f_wout)
        g = v * x1
        y = (bidir_long_conv(g, h_f, h_b) + g * f_bias) * x0
        return y @ w_out + b_out

    yl = operator(ul)
    if not need_ctx:
        return None, yl
    return operator(uc), yl


def diff_mixer(uc, ul, w_qkv, lambdas, subln_g, w_o, lambda_init, cos, sin, need_ctx):
    B, C, _ = uc.shape
    L = ul.shape[1]
    S = C + L
    qkv = jnp.concatenate([uc, ul], axis=1) @ w_qkv
    q, k, v = jnp.split(qkv, 3, axis=-1)
    q = q.reshape(B, S, DF_HEADS, 2, DF_HEAD_DIM)
    k = k.reshape(B, S, DF_HEADS, 2, DF_HEAD_DIM)
    v = v.reshape(B, S, DF_HEADS, 2 * DF_HEAD_DIM)
    q = jnp.concatenate([q[:, :C], apply_axial_rope(q[:, C:], cos, sin)], axis=1)
    k = jnp.concatenate([k[:, :C], apply_axial_rope(k[:, C:], cos, sin)], axis=1)
    lf = lambdas.astype(jnp.float32)
    lam = jnp.exp(jnp.sum(lf[0] * lf[1])) - jnp.exp(jnp.sum(lf[2] * lf[3])) + lambda_init
    scale = DF_HEAD_DIM ** -0.5

    def head_out(o):
        o = rmsnorm(o, subln_g, eps=DF_SUBLN_EPS) * (1.0 - lambda_init)
        return o.reshape(o.shape[0], o.shape[1], DF_HEADS * 2 * DF_HEAD_DIM) @ w_o

    ol = sweep_query_blocks(lambda qb: diff_attend(qb, k, v, lam, scale), q[:, C:])
    yl = head_out(ol)
    if not need_ctx:
        return None, yl
    oc = diff_attend(q[:, :C], k[:, :C], v[:, :C], lam, scale)
    return head_out(oc), yl


def sq_relu_mlp(x, w1, w2):
    return jnp.square(jax.nn.relu(x @ w1)) @ w2


def setup_inputs(seed: int = 0) -> dict:
    key = jax.random.key(seed)
    keys = jax.random.split(key, 40)
    cnt = [0]

    def nk():
        k = keys[cnt[0]]
        cnt[0] += 1
        return k

    def normal(shape):
        return jax.random.normal(nk(), shape, jnp.float32)

    def dense(shape, fan_in, gain=1.0):
        return normal(shape) * (gain * fan_in ** -0.5)

    def gains(shape):
        return 1.0 + 0.05 * normal(shape)

    def small(shape, s=0.01):
        return s * normal(shape)

    D = D_MODEL
    return {
        'x': normal((BATCH, SEQ, D)),
        'c': normal((BATCH, D)),
        'ctx': normal((BATCH, CTX_LEN, D)),
        'c_ctx': normal((D,)),
        'ada_w': dense((DEPTH, D, 6 * D), D, 0.5),
        'ada_b': small((DEPTH, 6 * D)),
        'norm_g': gains((DEPTH, 2, D)),
        'mlp_w1': dense((DEPTH, D, D_FF), D),
        'mlp_w2': dense((DEPTH, D_FF, D), D_FF),
        'final_norm_g': gains((D,)),
        'mla_w_dq': dense((N_LAYERS_A, D, MLA_Q_RANK), D),
        'mla_q_norm_g': gains((N_LAYERS_A, MLA_Q_RANK)),
        'mla_w_uq': dense((N_LAYERS_A, MLA_Q_RANK, MLA_HEADS * (MLA_NOPE + MLA_ROPE)), MLA_Q_RANK),
        'mla_w_dkv': dense((N_LAYERS_A, D, MLA_KV_RANK + MLA_ROPE), D),
        'mla_kv_norm_g': gains((N_LAYERS_A, MLA_KV_RANK)),
        'mla_w_ukv': dense((N_LAYERS_A, MLA_KV_RANK, MLA_HEADS * (MLA_NOPE + MLA_V)), MLA_KV_RANK),
        'mla_w_o': dense((N_LAYERS_A, MLA_HEADS * MLA_V, D), MLA_HEADS * MLA_V),
        'hy_w_in': dense((N_LAYERS_B, D, 3 * D), D),
        'hy_b_in': small((N_LAYERS_B, 3 * D)),
        'hy_conv_w': dense((N_LAYERS_B, HY_SHORT, 3 * D), HY_SHORT),
        'hy_conv_b': small((N_LAYERS_B, 3 * D)),
        'hy_filt_w1': dense((N_LAYERS_B, HY_EMB_DIM, HY_FILT_ORDER), HY_EMB_DIM),
        'hy_filt_b1': small((N_LAYERS_B, HY_FILT_ORDER), 0.1),
        'hy_filt_w2': dense((N_LAYERS_B, HY_FILT_ORDER, HY_FILT_ORDER), HY_FILT_ORDER),
        'hy_filt_b2': small((N_LAYERS_B, HY_FILT_ORDER), 0.1),
        'hy_filt_w3': dense((N_LAYERS_B, HY_FILT_ORDER, HY_FILT_ORDER), HY_FILT_ORDER),
        'hy_filt_b3': small((N_LAYERS_B, HY_FILT_ORDER), 0.1),
        'hy_filt_freq': gains((N_LAYERS_B, 3, HY_FILT_ORDER)),
        'hy_filt_wout': dense((N_LAYERS_B, HY_FILT_ORDER, 2 * D), HY_FILT_ORDER, 0.1),
        'hy_filt_bias': small((N_LAYERS_B, D), 0.5),
        'hy_w_out': dense((N_LAYERS_B, D, D), D),
        'hy_b_out': small((N_LAYERS_B, D)),
        'df_w_qkv': dense((N_LAYERS_C, D, 3 * D), D),
        'df_lambda': small((N_LAYERS_C, 4, DF_HEAD_DIM), 0.1),
        'df_subln_g': gains((N_LAYERS_C, 2 * DF_HEAD_DIM)),
        'df_w_o': dense((N_LAYERS_C, D, D), D),
    }


def reference(x, c, ctx, c_ctx, ada_w, ada_b, norm_g, mlp_w1, mlp_w2, final_norm_g,
              mla_w_dq, mla_q_norm_g, mla_w_uq, mla_w_dkv, mla_kv_norm_g, mla_w_ukv, mla_w_o,
              hy_w_in, hy_b_in, hy_conv_w, hy_conv_b, hy_filt_w1, hy_filt_b1, hy_filt_w2, hy_filt_b2,
              hy_filt_w3, hy_filt_b3, hy_filt_freq, hy_filt_wout, hy_filt_bias, hy_w_out, hy_b_out,
              df_w_qkv, df_lambda, df_subln_g, df_w_o):
    L = x.shape[1]
    cos_a, sin_a = axial_rope_tables(L, MLA_ROPE)
    cos_d, sin_d = axial_rope_tables(L, DF_HEAD_DIM)
    s_lat = jax.nn.silu(c)
    s_ctx = jax.nn.silu(c_ctx)
    hl, hc = x, ctx
    for i in range(DEPTH):
        need_ctx = i < DEPTH - 1
        sh1, sc1, g1, sh2, sc2, g2 = [m[:, None, :] for m in jnp.split(s_lat @ ada_w[i] + ada_b[i], 6, axis=-1)]
        csh1, csc1, cg1, csh2, csc2, cg2 = jnp.split(s_ctx @ ada_w[i] + ada_b[i], 6, axis=-1)
        ul = modulate(rmsnorm(hl, norm_g[i, 0]), sh1, sc1)
        uc = modulate(rmsnorm(hc, norm_g[i, 0]), csh1, csc1)
        kind, j = i % N_MIXERS, i // N_MIXERS
        if kind == 0:
            yc, yl = mla_mixer(uc, ul, mla_w_dq[j], mla_q_norm_g[j], mla_w_uq[j], mla_w_dkv[j],
                               mla_kv_norm_g[j], mla_w_ukv[j], mla_w_o[j], cos_a, sin_a, need_ctx)
        elif kind == 1:
            yc, yl = hyena_mixer(uc, ul, hy_w_in[j], hy_b_in[j], hy_conv_w[j], hy_conv_b[j],
                                 hy_filt_w1[j], hy_filt_b1[j], hy_filt_w2[j], hy_filt_b2[j],
                                 hy_filt_w3[j], hy_filt_b3[j], hy_filt_freq[j], hy_filt_wout[j],
                                 hy_filt_bias[j], hy_w_out[j], hy_b_out[j], need_ctx)
        else:
            lambda_init = 0.8 - 0.6 * math.exp(-0.3 * i)
            yc, yl = diff_mixer(uc, ul, df_w_qkv[j], df_lambda[j], df_subln_g[j], df_w_o[j],
                                lambda_init, cos_d, sin_d, need_ctx)
        hl = hl + g1 * yl
        hl = hl + g2 * sq_relu_mlp(modulate(rmsnorm(hl, norm_g[i, 1]), sh2, sc2), mlp_w1[i], mlp_w2[i])
        if need_ctx:
            hc = hc + cg1 * yc
            hc = hc + cg2 * sq_relu_mlp(modulate(rmsnorm(hc, norm_g[i, 1]), csh2, csc2), mlp_w1[i], mlp_w2[i])
    return rmsnorm(hl, final_norm_g)
```

```cpp
#include <hip/hip_runtime.h>
#include <cstdio>
#include <cstdint>
#include <cstring>

#define GAS __attribute__((address_space(1)))
#define LAS __attribute__((address_space(3)))
typedef unsigned short bf16;
typedef short bf16x8 __attribute__((ext_vector_type(8)));
typedef short s16x4 __attribute__((ext_vector_type(4)));
typedef float f32x4 __attribute__((ext_vector_type(4)));
typedef float f32x2 __attribute__((ext_vector_type(2)));
typedef float f32x16 __attribute__((ext_vector_type(16)));
typedef unsigned u32x4 __attribute__((ext_vector_type(4)));
typedef unsigned u32x2 __attribute__((ext_vector_type(2)));

#ifndef PROBE_DUP
#define PROBE_DUP 0
#endif
constexpr int DM = 2048, NBATCH = 16, SEQ = 2048, CTXL = 256, DFF = 8192;
constexpr int TC = NBATCH * CTXL, TL = NBATCH * SEQ, TT = TC + TL;
constexpr int NMOD = 6 * DM;
constexpr int NWAVES = 8, NTHREADS = 512;
constexpr int LDS_BYTES = 147456;
constexpr int MISC_OFF = LDS_BYTES - 256;

constexpr size_t MiB = 1u << 20;
constexpr size_t WS_CTL = 0, CTL_ZERO_BYTES = 4 * MiB;
constexpr size_t WS_SSQ = 64 * 1024;
constexpr size_t WS_TAB = 4 * MiB;
constexpr size_t WS_MOD = 4 * MiB + 65536;
constexpr size_t WS_GC = 8 * MiB;
constexpr size_t WS_SHW = 10 * MiB;
constexpr size_t WS_KFL = 14 * MiB;
constexpr size_t WS_KFC = 30 * MiB;
constexpr size_t WS_W = 32 * MiB;
constexpr size_t W_DQKV = 0, W_UQ = 12 * MiB, W_UKV = 21 * MiB, W_WOA = 29 * MiB, W_HYIN = 45 * MiB, W_HYOUT = 69 * MiB,
                 W_DFQKV = 77 * MiB, W_DFWO = 101 * MiB, W_W1 = 109 * MiB, W_W2 = 237 * MiB, W_END = 365 * MiB;
constexpr size_t WS_H = WS_W + W_END;
constexpr size_t WS_R = WS_H + 288 * MiB;
constexpr size_t R_XGB = 600 * MiB;
constexpr size_t WS_END = WS_R + 744 * MiB;
constexpr int CW_BAR = 4096;

__device__ __forceinline__ unsigned cvt_pk_bf16(float lo, float hi) { unsigned r; asm volatile("v_cvt_pk_bf16_f32 %0, %1, %2" : "=v"(r) : "v"(lo), "v"(hi)); return r; }
__device__ __forceinline__ float bf2f(unsigned short b) { return __uint_as_float(((unsigned)b) << 16); }
__device__ __forceinline__ unsigned short f2bf(float f) { return (unsigned short)(cvt_pk_bf16(f, 0.f) & 0xffffu); }
template <int CTRL> __device__ __forceinline__ float dpp_mov(float v) { return __builtin_bit_cast(float, __builtin_amdgcn_update_dpp(0, __builtin_bit_cast(int, v), CTRL, 0xf, 0xf, true)); }
__device__ __forceinline__ float rows_sum(float v) {
    auto a = __builtin_amdgcn_permlane16_swap(__float_as_uint(v), __float_as_uint(v), false, false); v = __uint_as_float(a[0]) + __uint_as_float(a[1]);
    auto b = __builtin_amdgcn_permlane32_swap(__float_as_uint(v), __float_as_uint(v), false, false); return __uint_as_float(b[0]) + __uint_as_float(b[1]);
}
__device__ __forceinline__ float wave_sum(float v) {
    v += dpp_mov<0xB1>(v);
    v += dpp_mov<0x4E>(v);
    v += dpp_mov<0x141>(v);
    v += dpp_mov<0x140>(v);
    return rows_sum(v);
}
__device__ __forceinline__ float half_sum(float v) {
    v += dpp_mov<0xB1>(v); v += dpp_mov<0x4E>(v); v += dpp_mov<0x141>(v); v += dpp_mov<0x140>(v);
    auto a = __builtin_amdgcn_permlane16_swap(__float_as_uint(v), __float_as_uint(v), false, false); return __uint_as_float(a[0]) + __uint_as_float(a[1]);
}
__device__ __forceinline__ int tid_fresh(int wv) { unsigned m = ~0u; asm volatile("" : "+s"(m)); int t = (wv << 6) | (int)__builtin_amdgcn_mbcnt_hi(m, __builtin_amdgcn_mbcnt_lo(m, 0u)); asm volatile("" : "+v"(t)); return t; }
template <class T> __device__ __forceinline__ T* fresh(T* p) { GAS T* g = (GAS T*)p; asm volatile("" : "+s"(g)); return (T*)g; }
__device__ __forceinline__ const float* in_ptr(int i) {
    auto ka = __builtin_amdgcn_kernarg_segment_ptr(); int ii = i; asm volatile("" : "+s"(ii));
    const GAS float* p = ((const GAS float* const __attribute__((address_space(4)))*)ka)[ii]; return (const float*)p; }
#define LDS_WAIT() asm volatile("s_waitcnt lgkmcnt(0)" ::: "memory")
#define VM_WAIT() asm volatile("s_waitcnt vmcnt(0)" ::: "memory")

#define XB_TMO      128
#define XB_XCNT(j)  (256  + 64 * (j))
#define XB_XSUB(j)  (1280 + 64 * (j))
#define XB_XGEN(j)  (2304 + 64 * (j))
#define XB_TOP      3328
#define XB_TOPGEN   3392
#define XCD_BAR_WORDS 3456
#define XB_SPIN_CAP (1u << 20)
__device__ __forceinline__ unsigned xb_ld(unsigned* p)              { return __hip_atomic_load(p, __ATOMIC_RELAXED, __HIP_MEMORY_SCOPE_AGENT); }
__device__ __forceinline__ unsigned xb_add(unsigned* p, unsigned v) { return __hip_atomic_fetch_add(p, v, __ATOMIC_RELAXED, __HIP_MEMORY_SCOPE_AGENT); }
__device__ __forceinline__ unsigned xb_xcc_id() { return (unsigned)__builtin_amdgcn_s_getreg((3 << 11) | 20) & 0xFu; }
#define XB_SPIN(cond, bar) do { unsigned _sp = 0; while (cond) { __builtin_amdgcn_s_sleep(1); \
    if ((++_sp & 255u) == 0u) { if (xb_ld(&(bar)[XB_TMO])) break; if (_sp > XB_SPIN_CAP) { atomicAdd(&(bar)[XB_TMO], 1u); break; } } } } while (0)
struct XcdBarrier { unsigned* bar; unsigned x; volatile LAS unsigned* st; };
__device__ __forceinline__ XcdBarrier xcd_barrier_post(unsigned* bar, volatile LAS unsigned* st) {
    XcdBarrier b; b.bar = bar; b.x = xb_xcc_id(); b.st = st;
    if (threadIdx.x == 0) (void)xb_add(&bar[XB_XCNT(b.x)], 1u);
    return b;
}
__device__ __forceinline__ void xcd_barrier_complete(unsigned* bar, unsigned x, unsigned G, unsigned& nloc, unsigned& nx) {
    unsigned sum, cnt, mine, sp = 0u;
    for (;;) {
        sum = 0u; cnt = 0u; mine = 0u;
#pragma unroll 1
        for (unsigned j = 0; j < 16; ++j) { const unsigned c = xb_ld(&bar[XB_XCNT(j)]); sum += c; cnt += (c > 0u) ? 1u : 0u; mine = (j == x) ? c : mine; }
        if (sum == G) break;
        __builtin_amdgcn_s_sleep(1);
        if ((++sp & 255u) == 0u) { if (xb_ld(&bar[XB_TMO])) break; if (sp > XB_SPIN_CAP) { atomicAdd(&bar[XB_TMO], 1u); break; } }
    }
    nloc = mine > 0u ? mine : 1u; nx = cnt > 0u ? cnt : 1u;
}
__device__ __noinline__ void xcd_barrier(unsigned* bar_, unsigned bx_, volatile LAS unsigned* st_, int leader, unsigned G) {
    XcdBarrier b; b.bar = bar_; b.x = bx_; b.st = st_;
    asm volatile("s_waitcnt vmcnt(0) lgkmcnt(0)" ::: "memory");
    __builtin_amdgcn_s_barrier(); asm volatile("" ::: "memory");
    if (leader) {
        unsigned* bar = b.bar;
        __builtin_amdgcn_s_waitcnt(0);
        unsigned nloc = b.st[0], nx = b.st[1];
        if (nloc == 0u) { xcd_barrier_complete(bar, b.x, G, nloc, nx); b.st[0] = nloc; b.st[1] = nx; }
        const unsigned old = xb_add(&bar[XB_XSUB(b.x)], 1u);
        const unsigned gen = old / nloc;
        if (old + 1u == (gen + 1u) * nloc) {
            __builtin_amdgcn_fence(__ATOMIC_RELEASE, "agent");
            asm volatile("s_waitcnt vmcnt(0)" ::: "memory");
            const unsigned og = xb_add(&bar[XB_TOP], 1u);
            const unsigned tg = og / nx;
            if (og + 1u == (tg + 1u) * nx) xb_add(&bar[XB_TOPGEN], 1u);
            else XB_SPIN(xb_ld(&bar[XB_TOPGEN]) == tg, bar);
            __builtin_amdgcn_fence(__ATOMIC_ACQUIRE, "agent");
            xb_add(&bar[XB_XGEN(b.x)], 1u);
            asm volatile("s_waitcnt vmcnt(0)" ::: "memory");
        } else {
            XB_SPIN(xb_ld(&bar[XB_XGEN(b.x)]) == gen, bar);
            __builtin_amdgcn_fence(__ATOMIC_ACQUIRE, "agent");
            asm volatile("s_waitcnt vmcnt(0)" ::: "memory");
        }
    }
    asm volatile("s_waitcnt lgkmcnt(0)" ::: "memory");
    __builtin_amdgcn_s_barrier(); asm volatile("" ::: "memory");
}

namespace pg8 {
constexpr int BM = 256, BK = 64, HALF = 128, HTB = HALF * BK * 2, STAGE_BYTES = 8 * HTB, NXCD = 8, WGM = 8;
__host__ __device__ __forceinline__ int lds_byte(int r, int c) { const int st = (r >> 4) * 2 + (c >> 5), rr = r & 15, cc = c & 31, ob = rr * 64 + cc * 2; return st * 1024 + (ob ^ (((ob >> 9) & 1) << 5)); }
__host__ __device__ __forceinline__ void stage_rc(int b, int& R, int& C) { const int st = b / 1024, sb = b % 1024, swz = sb ^ (((sb >> 9) & 1) << 5); R = (st >> 1) * 16 + swz / 64; C = (st & 1) * 32 + (swz % 64) / 2; }
__host__ __device__ __forceinline__ int perm32(int rho) { const int n = rho >> 4, i = rho & 15; return 8 * (i >> 2) + 4 * n + (i & 3); }
__host__ __device__ __forceinline__ size_t aimg_off(int rp, int c) { return (size_t)(c >> 6) * (BM * 64) + (size_t)(rp >> 7) * (HALF * 64) + (size_t)(lds_byte(rp & 127, c & 63) >> 1); }
__host__ __device__ __forceinline__ size_t wimg_off(int n, int k, int K) {
    const int pn = n >> 8, h = (n >> 7) & 1, x = n & 127, xl = x & 31;
    const int rho = 16 * ((xl >> 2) & 1) + 4 * (xl >> 3) + (xl & 3);
    const int R = (x & ~31) + rho;
    return ((size_t)(pn * (K >> 6) + (k >> 6)) * 2 + h) * 16384 + (size_t)lds_byte(R, k & 63);
}
struct Unit { int pm, pn; };
struct Gemm { const bf16* A; const bf16* Bt; int M, N, K; int a_blocked; };
struct StaticOrder {
    int nM, nN, nwg, G, c, wgm;
    __device__ void init(int M, int N, int G_, int c_) { nM = M / BM; nN = N / BM; nwg = nM * nN; G = G_; c = c_; wgm = WGM; }
    __device__ bool next(int i, Unit& u) const {
        const long L = (long)i * G + c; if (L >= nwg) return false;
        int wgid = (int)L; { const int q = nwg / NXCD, r = nwg % NXCD, xcd = wgid % NXCD, off = wgid / NXCD; wgid = (xcd < r ? xcd * (q + 1) : r * (q + 1) + (xcd - r) * q) + off; }
        const int nig = wgm * nN, gid = wgid / nig, fm = gid * wgm, gsz = (nM - fm) < wgm ? (nM - fm) : wgm;
        u.pm = fm + ((wgid % nig) % gsz); u.pn = (wgid % nig) / gsz; return true;
    }
};
constexpr int PREF_OFF = 131072 + 4096;
template <class Epi>
__device__ __forceinline__ void gemm_phase(LAS unsigned char* lds, const Gemm g, const StaticOrder& S, const Epi& E, int wv) {
    const int tid = tid_fresh(wv), wid = __builtin_amdgcn_readfirstlane(tid >> 6), lane = tid & 63, wr = wid >> 2, wc = wid & 3, fr = lane & 15, fq = lane >> 4;
    static_assert(Epi::PERM, "the weight image in d_ws has the PERM row order baked in");
    const int K = g.K, nt = K / BK;
    unsigned voffA[2], voffB[2];
#pragma unroll
    for (int i = 0; i < 2; ++i) { int R, C; stage_rc(tid * 16 + i * 8192, R, C); const int Rb = Epi::PERM ? ((R & ~31) + perm32(R & 31)) : R;
        voffA[i] = (unsigned)(tid * 16 + i * 8192); voffB[i] = (unsigned)(tid * 16 + i * 8192); (void)Rb; (void)C; }
    const size_t tstep = (size_t)BM * K * 2;
    const size_t kstepA = (size_t)(BM * BK * 2), hstepA = (size_t)(HALF * BK * 2);
    const size_t kstep = (size_t)(BM * BK * 2), hstep = (size_t)(HALF * BK * 2);
    const unsigned ldsw = (unsigned)wid * 1024u;
    const int aoff = lds_byte(wr * 64 + fr, fq * 8), boff = lds_byte(wc * 32 + fr, fq * 8);
#define PG8_SA(b, h) (((b) * 2 + (h)) * HTB)
#define PG8_SB(b, h) ((4 + (b) * 2 + (h)) * HTB)
#define PG8_STAGE(bufoff, gbase, voff) do { _Pragma("unroll") for (int _i = 0; _i < 2; ++_i) \
        __builtin_amdgcn_global_load_lds((const unsigned*)((const char*)(gbase) + (voff)[_i]), (LAS unsigned*)(lds + (bufoff) + ldsw + _i * 8192), 16, 0, 0); } while (0)
#define PG8_LDA(dst, b, h) do { _Pragma("unroll") for (int m = 0; m < 4; ++m) _Pragma("unroll") for (int k = 0; k < 2; ++k) dst[m][k] = *(const LAS bf16x8*)(lds + PG8_SA(b, h) + aoff + m * 2048 + k * 1024); } while (0)
#define PG8_LDB(dst, b, h) do { _Pragma("unroll") for (int n = 0; n < 2; ++n) _Pragma("unroll") for (int k = 0; k < 2; ++k) dst[n][k] = *(const LAS bf16x8*)(lds + PG8_SB(b, h) + boff + n * 2048 + k * 1024); } while (0)
#define PG8_MMA(ai, bj, At, Bt) do { __builtin_amdgcn_s_setprio(0); _Pragma("unroll") for (int m = 0; m < 4; ++m) _Pragma("unroll") for (int n = 0; n < 2; ++n) _Pragma("unroll") for (int k = 0; k < 2; ++k) \
        acc[ai][bj][m][n] = __builtin_amdgcn_mfma_f32_16x16x32_bf16(Bt[n][k], At[m][k], acc[ai][bj][m][n], 0, 0, 0); __builtin_amdgcn_s_setprio(1); } while (0)
#define PG8_WAIT_V(n) asm volatile("s_waitcnt vmcnt(" #n ")" ::: "memory")
#define PG8_WAIT_L(n) asm volatile("s_waitcnt lgkmcnt(" #n ")" ::: "memory")
#define PG8_WAIT_VN(n) asm volatile("s_waitcnt vmcnt(%0)" :: "n"(n) : "memory")
#define PG8_BAR __builtin_amdgcn_s_barrier()
#define PG8_SCHED __builtin_amdgcn_sched_barrier(0)
    Unit cur, nxt; int ui = 0;
    if (!S.next(0, cur)) return;
    f32x4 acc[2][2][4][2];
#pragma unroll
    for (int a = 0; a < 2; ++a)
#pragma unroll
        for (int b = 0; b < 2; ++b)
#pragma unroll
            for (int m = 0; m < 4; ++m)
#pragma unroll
                for (int n = 0; n < 2; ++n) acc[a][b][m][n] = (f32x4){0.f, 0.f, 0.f, 0.f};
    bf16x8 At[4][2], B0[2][2], B1[2][2];
    const char* cA = (const char*)g.A + (size_t)cur.pm * tstep; const char* cB = (const char*)g.Bt + (size_t)cur.pn * tstep;
    PG8_STAGE(PG8_SB(0, 0), cB, voffB); PG8_STAGE(PG8_SB(0, 1), cB + hstep, voffB); PG8_STAGE(PG8_SA(0, 0), cA, voffA); PG8_STAGE(PG8_SA(0, 1), cA + hstepA, voffA);
    if (wr == 1) PG8_BAR;
    PG8_WAIT_V(2); PG8_BAR;
    PG8_STAGE(PG8_SB(1, 0), cB + kstep, voffB); PG8_STAGE(PG8_SA(1, 0), cA + kstepA, voffA); PG8_STAGE(PG8_SB(1, 1), cB + hstep + kstep, voffB);
    if constexpr (Epi::MIN_VM > 0) PG8_WAIT_V(0); else PG8_WAIT_V(6);
    PG8_BAR;
    for (;;) {
        const bool has_next = S.next(ui + 1, nxt);
        const char* nA = has_next ? (const char*)g.A + (size_t)nxt.pm * tstep : cA; const char* nB = has_next ? (const char*)g.Bt + (size_t)nxt.pn * tstep : cB;
#define PG8_ITER(FIRST) do { \
            const bool last = (t == nt - 2); \
            const char* a1 = cA + (size_t)(t + 1) * kstepA; \
            const char* a2 = last ? nA : cA + (size_t)(t + 2) * kstepA; const char* b2 = last ? nB : cB + (size_t)(t + 2) * kstep; \
            const char* a3 = a2 + kstepA; const char* b3 = b2 + kstep; \
            if constexpr (FIRST && Epi::PREF) E.pref_dma(cur, tid_fresh(wv), lds + PREF_OFF + (ui & 1) * 4096 + wid * 256); \
            PG8_LDB(B0, 0, 0); PG8_LDB(B1, 0, 1); PG8_SCHED; PG8_LDA(At, 0, 0); PG8_STAGE(PG8_SA(1, 1), a1 + hstepA, voffA); \
            if constexpr (FIRST && Epi::MIN_VM > 0) PG8_WAIT_VN(8 + Epi::MIN_VM); else PG8_WAIT_V(8); \
            PG8_WAIT_L(0); PG8_BAR; PG8_MMA(0, 0, At, B0); PG8_MMA(0, 1, At, B1); PG8_BAR; PG8_SCHED; \
            PG8_LDA(At, 0, 1); PG8_STAGE(PG8_SB(0, 0), b2, voffB); PG8_STAGE(PG8_SB(0, 1), b2 + hstep, voffB); PG8_STAGE(PG8_SA(0, 0), a2, voffA); \
            if constexpr (FIRST && Epi::MIN_VM > 0) PG8_WAIT_VN(8 + Epi::MIN_VM); else PG8_WAIT_V(8); \
            PG8_WAIT_L(0); PG8_BAR; PG8_MMA(1, 0, At, B0); PG8_MMA(1, 1, At, B1); PG8_BAR; PG8_SCHED; \
            PG8_LDB(B0, 1, 0); PG8_LDB(B1, 1, 1); PG8_SCHED; PG8_LDA(At, 1, 0); PG8_STAGE(PG8_SA(0, 1), a2 + hstepA, voffA); \
            PG8_WAIT_V(8); PG8_WAIT_L(0); PG8_BAR; PG8_MMA(0, 0, At, B0); PG8_MMA(0, 1, At, B1); \
            PG8_BAR; PG8_SCHED; \
            PG8_LDA(At, 1, 1); PG8_STAGE(PG8_SB(1, 0), b3, voffB); PG8_STAGE(PG8_SB(1, 1), b3 + hstep, voffB); PG8_STAGE(PG8_SA(1, 0), a3, voffA); \
            PG8_WAIT_V(8); PG8_WAIT_L(0); PG8_BAR; PG8_MMA(1, 0, At, B0); PG8_MMA(1, 1, At, B1); PG8_BAR; PG8_SCHED; \
        } while (0)
        { int t = 0; PG8_ITER(true); for (t = 2; t < nt; t += 2) PG8_ITER(false); }
#undef PG8_ITER
        if (wr == 0) PG8_BAR;
        { const int lane_e = tid_fresh(wv) & 63;
          E(acc, cur, wr, wc, lane_e & 15, lane_e >> 4, (LAS const float*)(lds + PREF_OFF + (ui & 1) * 4096)); }
        if constexpr (Epi::PROBE2) { if (PROBE_DUP == 7) E(acc, cur, wr, wc, fr, fq, (LAS const float*)(lds + PREF_OFF + (ui & 1) * 4096)); }
        if (!has_next) break;
#pragma unroll
        for (int a = 0; a < 2; ++a)
#pragma unroll
            for (int b = 0; b < 2; ++b)
#pragma unroll
                for (int m = 0; m < 4; ++m)
#pragma unroll
                    for (int n = 0; n < 2; ++n) acc[a][b][m][n] = (f32x4){0.f, 0.f, 0.f, 0.f};
        cur = nxt; cA = nA; cB = nB; ++ui;
        if (wr == 1) PG8_BAR;
    }
    PG8_WAIT_V(0);
    PG8_BAR; __builtin_amdgcn_s_setprio(0);
#undef PG8_SA
#undef PG8_SB
#undef PG8_STAGE
#undef PG8_LDA
#undef PG8_LDB
#undef PG8_MMA
#undef PG8_WAIT_V
#undef PG8_WAIT_L
#undef PG8_WAIT_VN
#undef PG8_BAR
#undef PG8_SCHED
}
}
using pg8::Unit; using pg8::BM; using pg8::HALF;

typedef unsigned long long u64;
struct Pre { const u64* ssq; const float* shw; int N; int row_off; float inv_n; };
__device__ __forceinline__ void pre_rstd(const Pre& P, int row0  , float (&rs)[2][4]) {
#pragma unroll
    for (int ai = 0; ai < 2; ++ai)
#pragma unroll
        for (int m = 0; m < 4; ++m) rs[ai][m] = P.ssq ? __builtin_amdgcn_rsqf((float)P.ssq[P.row_off + row0 + ai * HALF + m * 16] * P.inv_n + 1e-6f) : 1.0f;
}
__device__ __forceinline__ void pref_rstd(LAS const float* pf, const Pre& P, int r0, float (&rs)[2][4]) {
    LAS const unsigned* pu = (LAS const unsigned*)pf;
#pragma unroll
    for (int ai = 0; ai < 2; ++ai)
#pragma unroll
        for (int m = 0; m < 4; ++m) { const int r = r0 + ai * HALF + m * 16;
            rs[ai][m] = P.ssq ? __builtin_amdgcn_rsqf((float)(((u64)pu[512 + r] << 32) | pu[r]) * P.inv_n + 1e-6f) : 1.0f; }
}
__device__ __forceinline__ int bi_of(int grow0) { return grow0 < TC ? 16 : (grow0 - TC) / SEQ; }
struct EpiBf16 {
    static constexpr bool PERM = true, PROBE2 = true; static constexpr int MIN_VM = 16;
    bf16* O; int ldc; const float* bias; int act; Pre P; int blocked;
    static constexpr bool PREF = true;
    __device__ __forceinline__ void pref_dma(const Unit& u, int tid, LAS unsigned char* dst) const {
        const int i = tid & 255; const bool isrow = tid < 256;
        const unsigned* dummy = (const unsigned*)O;
        const unsigned* pr = P.ssq ? (const unsigned*)(P.ssq + P.row_off + u.pm * BM + i) : dummy;
        const unsigned* ps = P.shw ? (const unsigned*)(P.shw + (size_t)bi_of(P.row_off + u.pm * BM) * P.N + u.pn * BM + i) : dummy;
        const unsigned* pb = bias ? (const unsigned*)(bias + u.pn * BM + i) : dummy;
        __builtin_amdgcn_global_load_lds(isrow ? pr : ps, (LAS unsigned*)dst, 4, 0, 0);
        __builtin_amdgcn_global_load_lds(isrow ? pr + 1 : pb, (LAS unsigned*)(dst + 2048), 4, 0, 0);
    }
    __device__ __forceinline__ void operator()(const f32x4 (&acc)[2][2][4][2], const Unit& u, int wr, int wc, int fr, int fq, LAS const float* pf) const {
        const int row0 = u.pm * BM + wr * 64 + fr; const int col0 = u.pn * BM + wc * 32 + 8 * fq;
        float rs[2][4]; f32x4 bv[2][2];
        pref_rstd(pf, P, wr * 64 + fr, rs);
#pragma unroll
        for (int bj = 0; bj < 2; ++bj)
#pragma unroll
            for (int n = 0; n < 2; ++n) { const int ci = 256 + wc * 32 + 8 * fq + bj * HALF + 4 * n;
                bv[bj][n] = bias ? *(LAS const f32x4*)(pf + 512 + ci) : (f32x4){0.f, 0.f, 0.f, 0.f};
                if (P.shw) bv[bj][n] += *(LAS const f32x4*)(pf + ci); }
#pragma unroll
        for (int ai = 0; ai < 2; ++ai)
#pragma unroll
            for (int m = 0; m < 4; ++m) { bf16* rowp = blocked ? O + (size_t)u.pm * BM * ldc + pg8::aimg_off(wr * 64 + fr + ai * HALF + m * 16, col0)
                                                               : O + (size_t)(row0 + ai * HALF + m * 16) * ldc + col0;
                const int bjs = blocked ? 2 * BM * 64 : HALF;
#pragma unroll
                for (int bj = 0; bj < 2; ++bj) { f32x4 v0 = acc[ai][bj][m][0] * rs[ai][m] + bv[bj][0], v1 = acc[ai][bj][m][1] * rs[ai][m] + bv[bj][1];
                    if (act) {
#pragma unroll
                        for (int j = 0; j < 4; ++j) { const float a = fmaxf(v0[j], 0.f), b = fmaxf(v1[j], 0.f); v0[j] = a * a; v1[j] = b * b; } }
                    u32x4 w; w.x = cvt_pk_bf16(v0[0], v0[1]); w.y = cvt_pk_bf16(v0[2], v0[3]); w.z = cvt_pk_bf16(v1[0], v1[1]); w.w = cvt_pk_bf16(v1[2], v1[3]);
                    *(u32x4*)(rowp + bj * bjs) = w; } }
    }
};
struct EpiRope {
    static constexpr bool PERM = true, PROBE2 = false; static constexpr int MIN_VM = 16;
    bf16* O; int ldc; const f32x2* tab; int mode; Pre P;
    static constexpr bool PREF = true;
    __device__ __forceinline__ void pref_dma(const Unit& u, int tid, LAS unsigned char* dst) const {
        const int i = tid & 255; const bool isrow = tid < 256;
        const unsigned* dummy = (const unsigned*)O;
        const unsigned* pr = P.ssq ? (const unsigned*)(P.ssq + P.row_off + u.pm * BM + i) : dummy;
        const unsigned* ps = P.shw ? (const unsigned*)(P.shw + (size_t)bi_of(P.row_off + u.pm * BM) * P.N + u.pn * BM + i) : dummy;
        __builtin_amdgcn_global_load_lds(isrow ? pr : ps, (LAS unsigned*)dst, 4, 0, 0);
        __builtin_amdgcn_global_load_lds(isrow ? pr + 1 : dummy, (LAS unsigned*)(dst + 2048), 4, 0, 0);
    }
    __device__ __forceinline__ void operator()(const f32x4 (&acc)[2][2][4][2], const Unit& u, int wr, int wc, int fr, int fq, LAS const float* pf) const {
        const int row0 = u.pm * BM + wr * 64 + fr; const int col0 = u.pn * BM + wc * 32 + 8 * fq;
        const int row_off = P.row_off;
        const bool latent = (row_off + u.pm * BM) >= TC;
        float rs[2][4]; pref_rstd(pf, P, wr * 64 + fr, rs);
#pragma unroll
        for (int bj = 0; bj < 2; ++bj) {
            const int c0 = col0 + bj * HALF;
            int axis, f0, nf; bool rot;
            if (mode == 1) { const int w = c0 % 192; rot = latent && w >= 128; const int j0 = w - 128; axis = (j0 >> 5) & 1; f0 = (j0 & 31) >> 1; nf = 16; }
            else { rot = latent && c0 < 4096; const int j0 = c0 & 127; axis = j0 >> 6; f0 = (j0 & 63) >> 1; nf = 32; }
            f32x4 s0 = (f32x4){0.f, 0.f, 0.f, 0.f}, s1 = s0;
            if (P.shw) { s0 = *(LAS const f32x4*)(pf + 256 + wc * 32 + 8 * fq + bj * HALF); s1 = *(LAS const f32x4*)(pf + 256 + wc * 32 + 8 * fq + bj * HALF + 4); }
#pragma unroll
            for (int ai = 0; ai < 2; ++ai)
#pragma unroll
                for (int m = 0; m < 4; ++m) {
                    const int r = row0 + ai * HALF + m * 16;
                    f32x4 v0 = acc[ai][bj][m][0] * rs[ai][m] + s0, v1 = acc[ai][bj][m][1] * rs[ai][m] + s1;
                    if (rot) {
                        const int l = (row_off + r - TC) & (SEQ - 1); const int p = axis ? (l & 63) : (l >> 6);
                        const f32x4* tp = (const f32x4*)(tab + p * nf + f0);
                        const f32x4 t0 = tp[0], t1 = tp[1];
                        f32x4 o0, o1;
                        o0[0] = v0[0] * t0[0] - v0[1] * t0[1]; o0[1] = v0[1] * t0[0] + v0[0] * t0[1];
                        o0[2] = v0[2] * t0[2] - v0[3] * t0[3]; o0[3] = v0[3] * t0[2] + v0[2] * t0[3];
                        o1[0] = v1[0] * t1[0] - v1[1] * t1[1]; o1[1] = v1[1] * t1[0] + v1[0] * t1[1];
                        o1[2] = v1[2] * t1[2] - v1[3] * t1[3]; o1[3] = v1[3] * t1[2] + v1[2] * t1[3];
                        v0 = o0; v1 = o1;
                    }
                    u32x4 w; w.x = cvt_pk_bf16(v0[0], v0[1]); w.y = cvt_pk_bf16(v0[2], v0[3]); w.z = cvt_pk_bf16(v1[0], v1[1]); w.w = cvt_pk_bf16(v1[2], v1[3]);
                    *(u32x4*)(O + (size_t)r * ldc + c0) = w;
                }
        }
    }
};
struct EpiDqkv {
    static constexpr bool PERM = true, PROBE2 = false, PREF = false; static constexpr int MIN_VM = 0;
    bf16* CQ; bf16* CKV; bf16* KR; const float* qg; const float* kvg; const f32x2* tab; Pre P; u64* ssq_q; u64* ssq_kv; LAS float* Pl;
    __device__ __forceinline__ void operator()(const f32x4 (&acc)[2][2][4][2], const Unit& u, int wr, int wc, int fr, int fq, LAS const float* pf) const {
        const int row0 = u.pm * BM + wr * 64 + fr; const int tc0 = wc * 32 + 8 * fq;
        const int col0 = u.pn * BM + tc0;
        float rs[2][4]; pre_rstd(P, row0, rs);
        const float* shp = P.shw + (size_t)bi_of(P.row_off + u.pm * BM) * P.N + col0;
        if (u.pn < 5) {
            const bool isq = u.pn < 3;
            bf16* dst = isq ? CQ : CKV; const int ldd = isq ? 768 : 512; const int dc0 = (isq ? u.pn : u.pn - 3) * BM + tc0;
            const float* gn = (isq ? qg : kvg) + dc0;
            float ss[2][4];
#pragma unroll
            for (int ai = 0; ai < 2; ++ai)
#pragma unroll
                for (int m = 0; m < 4; ++m) ss[ai][m] = 0.f;
#pragma unroll
            for (int bj = 0; bj < 2; ++bj) {
                const f32x4 s0 = *(const f32x4*)(shp + bj * HALF), s1 = *(const f32x4*)(shp + bj * HALF + 4);
                const f32x4 g0 = *(const f32x4*)(gn + bj * HALF), g1 = *(const f32x4*)(gn + bj * HALF + 4);
#pragma unroll
                for (int ai = 0; ai < 2; ++ai)
#pragma unroll
                    for (int m = 0; m < 4; ++m) {
                        const f32x4 v0 = acc[ai][bj][m][0] * rs[ai][m] + s0, v1 = acc[ai][bj][m][1] * rs[ai][m] + s1;
                        ss[ai][m] += ((v0[0] * v0[0] + v0[1] * v0[1]) + (v0[2] * v0[2] + v0[3] * v0[3])) + ((v1[0] * v1[0] + v1[1] * v1[1]) + (v1[2] * v1[2] + v1[3] * v1[3]));
                        const f32x4 y0 = v0 * g0, y1 = v1 * g1;
                        u32x4 w; w.x = cvt_pk_bf16(y0[0], y0[1]); w.y = cvt_pk_bf16(y0[2], y0[3]); w.z = cvt_pk_bf16(y1[0], y1[1]); w.w = cvt_pk_bf16(y1[2], y1[3]);
                        *(u32x4*)(dst + (size_t)u.pm * BM * ldd + pg8::aimg_off(wr * 64 + fr + ai * HALF + m * 16, dc0 + bj * HALF)) = w;
                    }
            }
#pragma unroll
            for (int ai = 0; ai < 2; ++ai)
#pragma unroll
                for (int m = 0; m < 4; ++m) { float v = rows_sum(ss[ai][m]);
                    if (fq == 0) Pl[wc * 256 + ai * HALF + wr * 64 + m * 16 + fr] = v; }
            asm volatile("s_waitcnt lgkmcnt(0)" ::: "memory"); __builtin_amdgcn_s_barrier(); asm volatile("" ::: "memory");
            const int t = (wr * 4 + wc) * 64 + fq * 16 + fr;
            if (t < 256) { const float v = (Pl[t] + Pl[256 + t]) + (Pl[512 + t] + Pl[768 + t]);
                __hip_atomic_fetch_add((isq ? ssq_q : ssq_kv) + u.pm * BM + t, (u64)__float2ll_rn(v * 1048576.0f), __ATOMIC_RELAXED, __HIP_MEMORY_SCOPE_AGENT); }
        } else if (tc0 < 64) {
            const bool latent = (P.row_off + u.pm * BM) >= TC;
            const int axis = tc0 >> 5, f0 = (tc0 & 31) >> 1;
            const f32x4 s0 = *(const f32x4*)(shp), s1 = *(const f32x4*)(shp + 4);
#pragma unroll
            for (int ai = 0; ai < 2; ++ai)
#pragma unroll
                for (int m = 0; m < 4; ++m) {
                    const int r = row0 + ai * HALF + m * 16;
                    f32x4 v0 = acc[ai][0][m][0] * rs[ai][m] + s0, v1 = acc[ai][0][m][1] * rs[ai][m] + s1;
                    if (latent) {
                        const int l = (P.row_off + r - TC) & (SEQ - 1); const int p = axis ? (l & 63) : (l >> 6);
                        const f32x4* tp = (const f32x4*)(tab + p * 16 + f0);
                        const f32x4 t0 = tp[0], t1 = tp[1];
                        f32x4 o0, o1;
                        o0[0] = v0[0] * t0[0] - v0[1] * t0[1]; o0[1] = v0[1] * t0[0] + v0[0] * t0[1];
                        o0[2] = v0[2] * t0[2] - v0[3] * t0[3]; o0[3] = v0[3] * t0[2] + v0[2] * t0[3];
                        o1[0] = v1[0] * t1[0] - v1[1] * t1[1]; o1[1] = v1[1] * t1[0] + v1[0] * t1[1];
                        o1[2] = v1[2] * t1[2] - v1[3] * t1[3]; o1[3] = v1[3] * t1[2] + v1[2] * t1[3];
                        v0 = o0; v1 = o1;
                    }
                    u32x4 w; w.x = cvt_pk_bf16(v0[0], v0[1]); w.y = cvt_pk_bf16(v0[2], v0[3]); w.z = cvt_pk_bf16(v1[0], v1[1]); w.w = cvt_pk_bf16(v1[2], v1[3]);
                    *(u32x4*)(KR + (size_t)r * 64 + tc0) = w;
                }
        }
    }
};
struct EpiResid {
    static constexpr bool PERM = true, PROBE2 = false, PREF = false; static constexpr int MIN_VM = 0;
    bf16* H; const float* bias; const float* modl; int row_off; bf16* XG; const float* gc; u64* ssq; LAS float* Pl;
    const float* xin; const float* cin; float* fout;
    __device__ __forceinline__ void operator()(const f32x4 (&acc)[2][2][4][2], const Unit& u, int wr, int wc, int fr, int fq, LAS const float* pf) const {
        const int grow0 = row_off + u.pm * BM; const int bi = bi_of(grow0);
        const int row0 = grow0 + wr * 64 + fr, col0 = u.pn * BM + wc * 32 + 8 * fq;
        const float* gp = modl + (size_t)bi * NMOD + col0;
        const float* gcp = gc + (size_t)bi * DM + col0;
        const float* h32 = xin ? (grow0 < TC ? cin + (size_t)row0 * DM : xin + (size_t)(row0 - TC) * DM) : nullptr;
        float ss[2][4];
#pragma unroll
        for (int ai = 0; ai < 2; ++ai)
#pragma unroll
            for (int m = 0; m < 4; ++m) ss[ai][m] = 0.f;
#pragma unroll
        for (int bj = 0; bj < 2; ++bj) {
            const int co = bj * HALF;
            u32x4 hwa[2][4];
            if (!h32) {
#pragma unroll
                for (int ai = 0; ai < 2; ++ai)
#pragma unroll
                    for (int m = 0; m < 4; ++m) hwa[ai][m] = *(const u32x4*)(H + (size_t)row0 * DM + (size_t)(ai * HALF + m * 16) * DM + col0 + co);
            }
            const f32x4 gv0 = *(const f32x4*)(gp + co), gv1 = *(const f32x4*)(gp + co + 4);
            const f32x4 bv0 = bias ? *(const f32x4*)(bias + col0 + co) : (f32x4){0.f, 0.f, 0.f, 0.f}, bv1 = bias ? *(const f32x4*)(bias + col0 + co + 4) : (f32x4){0.f, 0.f, 0.f, 0.f};
            const f32x4 gc0 = gc ? *(const f32x4*)(gcp + co) : (f32x4){0.f, 0.f, 0.f, 0.f}, gc1 = gc ? *(const f32x4*)(gcp + co + 4) : (f32x4){0.f, 0.f, 0.f, 0.f};
            const int col = col0 + co;
#pragma unroll
            for (int ai = 0; ai < 2; ++ai) {
#pragma unroll
                for (int m = 0; m < 4; ++m) {
                    const size_t ro = (size_t)(ai * HALF + m * 16) * DM + col;
                    const size_t o = (size_t)row0 * DM + ro;
                    f32x4 h0, h1;
                    if (h32) { h0 = *(const f32x4*)(h32 + ro); h1 = *(const f32x4*)(h32 + ro + 4); }
                    else { const u32x4 hw = hwa[ai][m];
                        h0 = (f32x4){__uint_as_float(hw.x << 16), __uint_as_float(hw.x & 0xffff0000u), __uint_as_float(hw.y << 16), __uint_as_float(hw.y & 0xffff0000u)};
                        h1 = (f32x4){__uint_as_float(hw.z << 16), __uint_as_float(hw.z & 0xffff0000u), __uint_as_float(hw.w << 16), __uint_as_float(hw.w & 0xffff0000u)}; }
                    const f32x4 n0 = h0 + gv0 * (acc[ai][bj][m][0] + bv0), n1 = h1 + gv1 * (acc[ai][bj][m][1] + bv1);
                    if (fout) { float* fo = fout + (o - (size_t)TC * DM); *(f32x4*)fo = n0; *(f32x4*)(fo + 4) = n1; }
                    else { u32x4 w; w.x = cvt_pk_bf16(n0[0], n0[1]); w.y = cvt_pk_bf16(n0[2], n0[3]); w.z = cvt_pk_bf16(n1[0], n1[1]); w.w = cvt_pk_bf16(n1[2], n1[3]); *(u32x4*)(H + o) = w; }
                    if (gc) { const f32x4 x0 = n0 * gc0, x1 = n1 * gc1; u32x4 w; w.x = cvt_pk_bf16(x0[0], x0[1]); w.y = cvt_pk_bf16(x0[2], x0[3]); w.z = cvt_pk_bf16(x1[0], x1[1]); w.w = cvt_pk_bf16(x1[2], x1[3]);
                        *(u32x4*)(XG + (size_t)grow0 * DM + pg8::aimg_off(wr * 64 + fr + ai * HALF + m * 16, col)) = w;
                        ss[ai][m] += ((n0[0] * n0[0] + n0[1] * n0[1]) + (n0[2] * n0[2] + n0[3] * n0[3])) + ((n1[0] * n1[0] + n1[1] * n1[1]) + (n1[2] * n1[2] + n1[3] * n1[3])); }
                }
                asm volatile("" ::: "memory");
            }
        }
        if (gc) {
#pragma unroll
            for (int ai = 0; ai < 2; ++ai)
#pragma unroll
                for (int m = 0; m < 4; ++m) { float v = rows_sum(ss[ai][m]);
                    if (fq == 0) Pl[wc * 256 + ai * HALF + wr * 64 + m * 16 + fr] = v; }
            asm volatile("s_waitcnt lgkmcnt(0)" ::: "memory"); __builtin_amdgcn_s_barrier(); asm volatile("" ::: "memory");
            const int t = (wr * 4 + wc) * 64 + fq * 16 + fr;
            if (t < 256) { const float v = (Pl[t] + Pl[256 + t]) + (Pl[512 + t] + Pl[768 + t]);
                __hip_atomic_fetch_add(ssq + grow0 + t, (u64)__float2ll_rn(v * 1048576.0f), __ATOMIC_RELAXED, __HIP_MEMORY_SCOPE_AGENT); }
        }
    }
};

__device__ __forceinline__ void gemm_bf16(int wv, const bf16* A, const bf16* Bt, int M, int N, int K, bf16* O, int ldc, const float* bias, int act, Pre P, int blocked = 0, int a_blocked = 0) {
    extern __shared__ __attribute__((aligned(16))) unsigned char lds[];
    pg8::Gemm g{A, Bt, M, N, K, a_blocked}; pg8::StaticOrder S; S.init(M, N, (int)gridDim.x, (int)blockIdx.x);
    EpiBf16 E{O, ldc, bias, act, P, blocked}; pg8::gemm_phase<EpiBf16>((LAS unsigned char*)lds, g, S, E, wv);
}
__device__ __forceinline__ void gemm_rope(int wv, const bf16* A, const bf16* Bt, int M, int N, int K, bf16* O, int ldc, const f32x2* tab, int mode, Pre P, int a_blocked = 0) {
    extern __shared__ __attribute__((aligned(16))) unsigned char lds[];
    pg8::Gemm g{A, Bt, M, N, K, a_blocked}; pg8::StaticOrder S; S.init(M, N, (int)gridDim.x, (int)blockIdx.x);
    EpiRope E{O, ldc, tab, mode, P}; pg8::gemm_phase<EpiRope>((LAS unsigned char*)lds, g, S, E, wv);
}
__device__ __forceinline__ void gemm_dqkv(int wv, const bf16* A, const bf16* Bt, bf16* CQ, bf16* CKV, bf16* KR, const float* qg, const float* kvg, const f32x2* tab, Pre P, u64* ssq_q, u64* ssq_kv) {
    extern __shared__ __attribute__((aligned(16))) unsigned char lds[];
    pg8::Gemm g{A, Bt, TT, 1536, DM, 1}; pg8::StaticOrder S; S.init(TT, 1536, (int)gridDim.x, (int)blockIdx.x);
    EpiDqkv E{CQ, CKV, KR, qg, kvg, tab, P, ssq_q, ssq_kv, (LAS float*)((LAS unsigned char*)lds + 131072)}; pg8::gemm_phase<EpiDqkv>((LAS unsigned char*)lds, g, S, E, wv);
}
__device__ __forceinline__ void gemm_resid(int wv, const bf16* A, const bf16* Bt, int M, int N, int K, bf16* H, const float* bias, const float* modl, int row_off, bf16* XG, const float* gc, u64* ssq,
                                           const float* xin, const float* cin, float* fout, int a_blocked = 0) {
    extern __shared__ __attribute__((aligned(16))) unsigned char lds[];
    pg8::Gemm g{A, Bt, M, N, K, a_blocked}; pg8::StaticOrder S; S.init(M, N, (int)gridDim.x, (int)blockIdx.x); if (K == DFF) S.wgm = 4;
    EpiResid E{H, bias, modl, row_off, XG, gc, ssq, (LAS float*)((LAS unsigned char*)lds + 131072), xin, cin, fout}; pg8::gemm_phase<EpiResid>((LAS unsigned char*)lds, g, S, E, wv);
}

#define KSWZ(row, colB) ((row) * 256 + ((colB) ^ (((row) & 7) << 4)))
#define KRSWZ(row, colB) ((row) * 128 + ((colB) ^ ((((row) >> 1) & 7) << 4)))
#define SBAR() __builtin_amdgcn_sched_barrier(0)
__device__ __forceinline__ int crow(int r, int hi) { return (r & 3) + 8 * (r >> 2) + 4 * hi; }
constexpr int KVBLK = 64;
constexpr int SHM_V = KVBLK * 128 * 2, SHM_K = KVBLK * 128 * 2, SHM_KR = KVBLK * 64 * 2;
__device__ __forceinline__ void partialSM(f32x16& p0, f32x16& p1, float& m_reg, float& mn, float& alpha, float C, float thr) {
    float pmax = p0[0];
#pragma unroll
    for (int r = 1; r < 16; ++r) pmax = fmaxf(pmax, p0[r]);
#pragma unroll
    for (int r = 0; r < 16; ++r) pmax = fmaxf(pmax, p1[r]);
    { auto rr = __builtin_amdgcn_permlane32_swap(__float_as_uint(pmax), __float_as_uint(pmax), false, false);
      pmax = fmaxf(__uint_as_float(rr[0]), __uint_as_float(rr[1])); }
    if (__builtin_expect(__all(pmax - m_reg <= thr), 1)) { mn = m_reg; alpha = 1.f; }
    else { mn = fmaxf(m_reg, pmax); alpha = __builtin_amdgcn_exp2f((m_reg - mn) * C); m_reg = mn; }
    const float mnC = -mn * C;
#pragma unroll
    for (int r = 0; r < 16; ++r) p0[r] = fmaf(p0[r], C, mnC);
#pragma unroll
    for (int r = 0; r < 16; ++r) p1[r] = fmaf(p1[r], C, mnC);
#pragma unroll
    for (int r = 0; r < 16; ++r) p0[r] = __builtin_amdgcn_exp2f(p0[r]);
}
__device__ __forceinline__ void finishSM(f32x16& p0, f32x16& p1, float alpha, float& l_reg, bf16x8& pa0, bf16x8& pa1, bf16x8& pa2, bf16x8& pa3) {
#pragma unroll
    for (int r = 0; r < 16; ++r) p1[r] = __builtin_amdgcn_exp2f(p1[r]);
    float ps = 0;
#pragma unroll
    for (int r = 0; r < 16; ++r) ps += p0[r];
#pragma unroll
    for (int r = 0; r < 16; ++r) ps += p1[r];
    { auto rr = __builtin_amdgcn_permlane32_swap(__float_as_uint(ps), __float_as_uint(ps), false, false);
      ps = __uint_as_float(rr[0]) + __uint_as_float(rr[1]); }
    l_reg = l_reg * alpha + ps;
#define PK4(P, BASE, OUT) do { unsigned a0 = cvt_pk_bf16(P[BASE + 0], P[BASE + 1]), a1 = cvt_pk_bf16(P[BASE + 2], P[BASE + 3]);   \
    unsigned b0 = cvt_pk_bf16(P[BASE + 4], P[BASE + 5]), b1 = cvt_pk_bf16(P[BASE + 6], P[BASE + 7]);                              \
    auto r0 = __builtin_amdgcn_permlane32_swap(a0, b0, false, false); auto r1 = __builtin_amdgcn_permlane32_swap(a1, b1, false, false); \
    u32x4 w = {r0[0], r1[0], r0[1], r1[1]}; OUT = *reinterpret_cast<bf16x8*>(&w); } while (0)
    PK4(p0, 0, pa0); PK4(p0, 8, pa1); PK4(p1, 0, pa2); PK4(p1, 8, pa3);
#undef PK4
}
template <int NDQ>
__device__ __forceinline__ void qkt(f32x16& p0, f32x16& p1, const char* Ks, const char* Krs, const bf16x8* qr, const char* qrl, int r32, int hi) {
    p0 = f32x16{}; p1 = f32x16{};
#pragma unroll
    for (int d0 = 0; d0 < 8; ++d0) { const int cb = (d0 * 16 + hi * 8) * 2;
        const bf16x8 b0 = *reinterpret_cast<const bf16x8*>(Ks + KSWZ(r32, cb));
        const bf16x8 b1 = *reinterpret_cast<const bf16x8*>(Ks + KSWZ(32 + r32, cb));
        p0 = __builtin_amdgcn_mfma_f32_32x32x16_bf16(b0, qr[d0], p0, 0, 0, 0);
        p1 = __builtin_amdgcn_mfma_f32_32x32x16_bf16(b1, qr[d0], p1, 0, 0, 0); }
    if constexpr (NDQ > 8) {
#pragma unroll
        for (int d0 = 8; d0 < NDQ; ++d0) { const int cb = ((d0 - 8) * 16 + hi * 8) * 2;
            const bf16x8 b0 = *reinterpret_cast<const bf16x8*>(Krs + KRSWZ(r32, cb));
            const bf16x8 b1 = *reinterpret_cast<const bf16x8*>(Krs + KRSWZ(32 + r32, cb));
            const bf16x8 qf = *reinterpret_cast<const bf16x8*>(qrl + (d0 - 8) * 1024);
            p0 = __builtin_amdgcn_mfma_f32_32x32x16_bf16(b0, qf, p0, 0, 0, 0);
            p1 = __builtin_amdgcn_mfma_f32_32x32x16_bf16(b1, qf, p1, 0, 0, 0); }
    }
}
__device__ __forceinline__ int v_st(int k, int c) { const int kk = (k & ~0xC) | ((k & 4) << 1) | ((k & 8) >> 1); return ((kk >> 3) * 4 + (c >> 5)) * 512 + ((kk & 7) * 32 + (c & 31)) * 2; }
__device__ __forceinline__ int v_rd_base(int lane) { return ((lane & 3) << 3) | (((lane >> 2) & 3) << 6) | (((lane >> 4) & 1) << 5) | (((lane >> 5) & 1) << 8); }
constexpr int v_rd_off(int d0, int ks, int half) { return d0 * 512 + ks * 4096 + half * 2048; }
template <int OFF> __device__ __forceinline__ s16x4 tr_read(int vb) {
    s16x4 r; asm volatile("ds_read_b64_tr_b16 %0, %1 offset:%2" : "=&v"(r) : "v"(vb), "i"(OFF) : "memory"); return r;
}
template <int D0> __device__ __forceinline__ void pv_one(f32x16& od, int vb, bf16x8 pa0, bf16x8 pa1, bf16x8 pa2, bf16x8 pa3) {
    const s16x4 l0 = tr_read<v_rd_off(D0, 0, 0)>(vb), h0 = tr_read<v_rd_off(D0, 0, 1)>(vb), l1 = tr_read<v_rd_off(D0, 1, 0)>(vb), h1 = tr_read<v_rd_off(D0, 1, 1)>(vb);
    const s16x4 l2 = tr_read<v_rd_off(D0, 2, 0)>(vb), h2 = tr_read<v_rd_off(D0, 2, 1)>(vb), l3 = tr_read<v_rd_off(D0, 3, 0)>(vb), h3 = tr_read<v_rd_off(D0, 3, 1)>(vb);
    asm volatile("s_waitcnt lgkmcnt(0)" ::: "memory"); SBAR();
#define PK(L, H) (bf16x8){L[0], L[1], L[2], L[3], H[0], H[1], H[2], H[3]}
    od = __builtin_amdgcn_mfma_f32_32x32x16_bf16(pa0, PK(l0, h0), od, 0, 0, 0);
    od = __builtin_amdgcn_mfma_f32_32x32x16_bf16(pa1, PK(l1, h1), od, 0, 0, 0);
    od = __builtin_amdgcn_mfma_f32_32x32x16_bf16(pa2, PK(l2, h2), od, 0, 0, 0);
    od = __builtin_amdgcn_mfma_f32_32x32x16_bf16(pa3, PK(l3, h3), od, 0, 0, 0);
#undef PK
}
__device__ __forceinline__ void pv_d0(f32x16* o, int vb, bf16x8 pa0, bf16x8 pa1, bf16x8 pa2, bf16x8 pa3) {
    pv_one<0>(o[0], vb, pa0, pa1, pa2, pa3); pv_one<1>(o[1], vb, pa0, pa1, pa2, pa3); pv_one<2>(o[2], vb, pa0, pa1, pa2, pa3); pv_one<3>(o[3], vb, pa0, pa1, pa2, pa3);
}
template <int D0> __device__ __forceinline__ void pv_reads(int vb, s16x4 (&t)[8]) {
    t[0] = tr_read<v_rd_off(D0, 0, 0)>(vb); t[1] = tr_read<v_rd_off(D0, 0, 1)>(vb); t[2] = tr_read<v_rd_off(D0, 1, 0)>(vb); t[3] = tr_read<v_rd_off(D0, 1, 1)>(vb);
    t[4] = tr_read<v_rd_off(D0, 2, 0)>(vb); t[5] = tr_read<v_rd_off(D0, 2, 1)>(vb); t[6] = tr_read<v_rd_off(D0, 3, 0)>(vb); t[7] = tr_read<v_rd_off(D0, 3, 1)>(vb);
}
__device__ __forceinline__ void pv_mma(f32x16& od, s16x4 (&t)[8], bf16x8 pa0, bf16x8 pa1, bf16x8 pa2, bf16x8 pa3) {
#define PK(L, H) (bf16x8){L[0], L[1], L[2], L[3], H[0], H[1], H[2], H[3]}
    asm volatile("" : "+v"(t[0]), "+v"(t[1]), "+v"(t[2]), "+v"(t[3]), "+v"(t[4]), "+v"(t[5]), "+v"(t[6]), "+v"(t[7]));
    od = __builtin_amdgcn_mfma_f32_32x32x16_bf16(pa0, PK(t[0], t[1]), od, 0, 0, 0);
    od = __builtin_amdgcn_mfma_f32_32x32x16_bf16(pa1, PK(t[2], t[3]), od, 0, 0, 0);
    od = __builtin_amdgcn_mfma_f32_32x32x16_bf16(pa2, PK(t[4], t[5]), od, 0, 0, 0);
    od = __builtin_amdgcn_mfma_f32_32x32x16_bf16(pa3, PK(t[6], t[7]), od, 0, 0, 0);
#undef PK
}
__device__ __forceinline__ void pv_pipe(f32x16* o, int vb, bf16x8 pa0, bf16x8 pa1, bf16x8 pa2, bf16x8 pa3) {
    s16x4 ta[8], tb[8];
    pv_reads<0>(vb, ta);
    pv_reads<1>(vb, tb); asm volatile("s_waitcnt lgkmcnt(8)" ::: "memory"); SBAR(); pv_mma(o[0], ta, pa0, pa1, pa2, pa3);
    pv_reads<2>(vb, ta); asm volatile("s_waitcnt lgkmcnt(8)" ::: "memory"); SBAR(); pv_mma(o[1], tb, pa0, pa1, pa2, pa3);
    pv_reads<3>(vb, tb); asm volatile("s_waitcnt lgkmcnt(8)" ::: "memory"); SBAR(); pv_mma(o[2], ta, pa0, pa1, pa2, pa3);
    asm volatile("s_waitcnt lgkmcnt(0)" ::: "memory"); SBAR(); pv_mma(o[3], tb, pa0, pa1, pa2, pa3);
}
__device__ __forceinline__ void softmax_tile(f32x16& p0, f32x16& p1, float& m_reg, float& l_reg, float& alpha, float C, float thr, bf16x8& pa0, bf16x8& pa1, bf16x8& pa2, bf16x8& pa3) {
    float mn; partialSM(p0, p1, m_reg, mn, alpha, C, thr); (void)mn;
    finishSM(p0, p1, alpha, l_reg, pa0, pa1, pa2, pa3);
}
template <int NDQ>
__device__ __forceinline__ void attn_body2(int wv, const bf16* __restrict__ Qb, int ldq, const bf16* __restrict__ Kn, int ldk, const bf16* __restrict__ Kr,
                                           const bf16* __restrict__ V, int ldv, bf16* __restrict__ Ob, int ocol,
                                           int cbase, int lbase, int nct, int NT, float C, float thr, char* lds) {
    const int tid = tid_fresh(wv), wid = tid >> 6, lane = tid & 63, r32 = lane & 31, hi = lane >> 5;
    const bool lead = wid < 4;
    char* V_lds = lds; char* K_lds = lds + 2 * SHM_V; char* Kr_lds = lds + 2 * SHM_V + 2 * SHM_K;
    float* wsf = (float*)(lds + 2 * SHM_V + 2 * SHM_K + 2 * SHM_KR) + wid * 64; float* li_l = wsf; float* al_l = wsf + 32;
    float m_reg = -1e30f, l_reg = 0; f32x16 o[4] = {}; bf16x8 qr[8];
    const bf16* Qw = Qb + (size_t)(wid * 32 + r32) * ldq + hi * 8;
#pragma unroll
    for (int d0 = 0; d0 < 8; ++d0) qr[d0] = *reinterpret_cast<const bf16x8*>(Qw + d0 * 16);
    char* qrl = lds + 2 * SHM_V + 2 * SHM_K + 2 * SHM_KR + 2048 + wid * 4096 + lane * 16;
    if constexpr (NDQ > 8) {
#pragma unroll
        for (int d0 = 8; d0 < NDQ; ++d0) *reinterpret_cast<bf16x8*>(qrl + (d0 - 8) * 1024) = *reinterpret_cast<const bf16x8*>(Qw + d0 * 16);
        asm volatile("s_waitcnt lgkmcnt(0)" ::: "memory");
    }
    const int sr = tid >> 4, sc = (tid & 15) * 8, vst0 = v_st(sr, sc), vst1 = v_st(32 + sr, sc);
    const int rr = tid >> 3, rc = (tid & 7) * 8;
    const int vb0 = (int)(uintptr_t)V_lds + v_rd_base(lane);
    bf16x8 svs0, svs1, sks0, sks1, skr;
#define KROW2(j) ((j) < nct ? cbase + (j) * KVBLK : lbase + ((j) - nct) * KVBLK)
#define SLOAD2(j) do { const int k0_ = KROW2(j); svs0 = *reinterpret_cast<const bf16x8*>(&V[(size_t)(k0_ + sr) * ldv + sc]); svs1 = *reinterpret_cast<const bf16x8*>(&V[(size_t)(k0_ + 32 + sr) * ldv + sc]); \
    sks0 = *reinterpret_cast<const bf16x8*>(&Kn[(size_t)(k0_ + sr) * ldk + sc]); sks1 = *reinterpret_cast<const bf16x8*>(&Kn[(size_t)(k0_ + 32 + sr) * ldk + sc]); \
    if constexpr (NDQ > 8) skr = *reinterpret_cast<const bf16x8*>(&Kr[(size_t)(k0_ + rr) * 64 + rc]); } while (0)
#define SWRITE2(b) do { *(bf16x8*)(V_lds + (b) * SHM_V + vst0) = svs0; *(bf16x8*)(V_lds + (b) * SHM_V + vst1) = svs1; const int kc = sc * 2; \
    *(bf16x8*)(K_lds + (b) * SHM_K + KSWZ(sr, kc)) = sks0; *(bf16x8*)(K_lds + (b) * SHM_K + KSWZ(32 + sr, kc)) = sks1; \
    if constexpr (NDQ > 8) *(bf16x8*)(Kr_lds + (b) * SHM_KR + KRSWZ(rr, rc * 2)) = skr; } while (0)
#define RESC2(a) do { if (__any((a) < 1.f)) { if (hi == 0) al_l[r32] = (a); asm volatile("s_waitcnt lgkmcnt(0)" ::: "memory"); \
    _Pragma("unroll") for (int d = 0; d < 4; ++d) _Pragma("unroll") for (int r = 0; r < 16; ++r) o[d][r] *= al_l[crow(r, hi)]; } } while (0)
    f32x16 S0, S1; float alpha = 1.f; bf16x8 pa0, pa1, pa2, pa3;
    if (!lead) __builtin_amdgcn_s_setprio(1);
    SLOAD2(0); asm volatile("s_waitcnt vmcnt(0)" ::: "memory"); SWRITE2(0); __syncthreads();
    if (1 < NT) SLOAD2(1);
    SBAR(); qkt<NDQ>(S0, S1, K_lds, Kr_lds, qr, qrl, r32, hi); SBAR();
    if (lead) { softmax_tile(S0, S1, m_reg, l_reg, alpha, C, thr, pa0, pa1, pa2, pa3); }
    __syncthreads(); asm volatile("s_waitcnt vmcnt(0)" ::: "memory"); if (1 < NT) SWRITE2(1); __syncthreads();
    for (int j = 1; j < NT; ++j) {
        const int b = j & 1;
        if (j + 1 < NT) SLOAD2(j + 1);
        const char* Kb = K_lds + b * SHM_K; const char* Krb = Kr_lds + b * SHM_KR; const int vbp = vb0 + (b ^ 1) * SHM_V;
        if (lead) {
            SBAR(); pv_pipe(o, vbp, pa0, pa1, pa2, pa3); qkt<NDQ>(S0, S1, Kb, Krb, qr, qrl, r32, hi); SBAR();
            softmax_tile(S0, S1, m_reg, l_reg, alpha, C, thr, pa0, pa1, pa2, pa3); RESC2(alpha); SBAR();
        } else {
            SBAR(); softmax_tile(S0, S1, m_reg, l_reg, alpha, C, thr, pa0, pa1, pa2, pa3); RESC2(alpha); SBAR();
            qkt<NDQ>(S0, S1, Kb, Krb, qr, qrl, r32, hi); pv_pipe(o, vbp, pa0, pa1, pa2, pa3); SBAR();
        }
        __syncthreads(); asm volatile("s_waitcnt vmcnt(0)" ::: "memory"); if (j + 1 < NT) SWRITE2(b ^ 1); __syncthreads();
    }
    if (!lead) { softmax_tile(S0, S1, m_reg, l_reg, alpha, C, thr, pa0, pa1, pa2, pa3); RESC2(alpha); }
    SBAR(); pv_pipe(o, vb0 + ((NT - 1) & 1) * SHM_V, pa0, pa1, pa2, pa3);
    __builtin_amdgcn_s_setprio(0);
    if (hi == 0) li_l[r32] = l_reg; asm volatile("s_waitcnt lgkmcnt(0)" ::: "memory");
    float rli[16];
#pragma unroll
    for (int r = 0; r < 16; ++r) rli[r] = __builtin_amdgcn_rcpf(li_l[crow(r, hi)]);
    __syncthreads();
    { char* ost = lds + wid * 8704;
#pragma unroll
      for (int r = 0; r < 16; ++r) { const int orow = crow(r, hi);
#pragma unroll
          for (int d0 = 0; d0 < 4; ++d0) *(bf16*)(ost + orow * 272 + (d0 * 32 + r32) * 2) = f2bf(o[d0][r] * rli[r]); }
      asm volatile("s_waitcnt lgkmcnt(0)" ::: "memory");
#pragma unroll
      for (int i = 0; i < 8; ++i) { const int row = (lane >> 4) + 4 * i, chunk = lane & 15;
          const u32x4 v = *(const u32x4*)(ost + row * 272 + chunk * 16);
          *(u32x4*)(Ob + pg8::aimg_off(wid * 32 + row, ocol + chunk * 8)) = v; } }
    __syncthreads();
#undef KROW2
#undef SLOAD2
#undef SWRITE2
#undef RESC2
}
template <int NDV> __device__ __forceinline__ int v_st4(int k, int c) { const int kk = (k & ~0xC) | ((k & 4) << 1) | ((k & 8) >> 1); return ((kk >> 3) * NDV + (c >> 5)) * 512 + ((kk & 7) * 32 + (c & 31)) * 2; }
template <int NDV> constexpr int v_rd_off4(int d0, int ks, int half) { return d0 * 512 + ks * (2 * NDV * 512) + half * (NDV * 512); }
template <int D0, int NDV> __device__ __forceinline__ void pv_reads4(int vb, s16x4 (&t)[8]) {
    t[0] = tr_read<v_rd_off4<NDV>(D0, 0, 0)>(vb); t[1] = tr_read<v_rd_off4<NDV>(D0, 0, 1)>(vb); t[2] = tr_read<v_rd_off4<NDV>(D0, 1, 0)>(vb); t[3] = tr_read<v_rd_off4<NDV>(D0, 1, 1)>(vb);
    t[4] = tr_read<v_rd_off4<NDV>(D0, 2, 0)>(vb); t[5] = tr_read<v_rd_off4<NDV>(D0, 2, 1)>(vb); t[6] = tr_read<v_rd_off4<NDV>(D0, 3, 0)>(vb); t[7] = tr_read<v_rd_off4<NDV>(D0, 3, 1)>(vb);
}
template <int D0, int NDV> struct PvChain {
    static __device__ __forceinline__ void run(f32x16* o, int vb, bf16x8 pa0, bf16x8 pa1, bf16x8 pa2, bf16x8 pa3, s16x4 (&cur)[8], s16x4 (&nxt)[8]) {
        if constexpr (D0 + 1 < NDV) { pv_reads4<D0 + 1, NDV>(vb, nxt); asm volatile("s_waitcnt lgkmcnt(8)" ::: "memory"); } else { asm volatile("s_waitcnt lgkmcnt(0)" ::: "memory"); }
        SBAR(); pv_mma(o[D0], cur, pa0, pa1, pa2, pa3);
        if constexpr (D0 + 1 < NDV) PvChain<D0 + 1, NDV>::run(o, vb, pa0, pa1, pa2, pa3, nxt, cur);
    }
};
template <int D0, int NDV> struct PvSeq {
    static __device__ __forceinline__ void run(f32x16* o, int vb, bf16x8 pa0, bf16x8 pa1, bf16x8 pa2, bf16x8 pa3) {
        s16x4 t[8]; pv_reads4<D0, NDV>(vb, t); asm volatile("s_waitcnt lgkmcnt(0)" ::: "memory"); SBAR(); pv_mma(o[D0], t, pa0, pa1, pa2, pa3);
        if constexpr (D0 + 1 < NDV) PvSeq<D0 + 1, NDV>::run(o, vb, pa0, pa1, pa2, pa3);
    }
};
template <int NDV> __device__ __forceinline__ void pv_pipe4(f32x16* o, int vb, bf16x8 pa0, bf16x8 pa1, bf16x8 pa2, bf16x8 pa3) {
    if constexpr (NDV > 8) { PvSeq<0, NDV>::run(o, vb, pa0, pa1, pa2, pa3); }
    else { s16x4 ta[8], tb[8]; pv_reads4<0, NDV>(vb, ta); PvChain<0, NDV>::run(o, vb, pa0, pa1, pa2, pa3, ta, tb); }
}
template <int D0, int NQR> __device__ __forceinline__ void qk_read1(const char* Ks, const char* Krs, const char* qrl, int r32, int hi, bf16x8& b0, bf16x8& b1, bf16x8& qf) {
    if constexpr (D0 < 8) { const int cb = (D0 * 16 + hi * 8) * 2; b0 = *reinterpret_cast<const bf16x8*>(Ks + KSWZ(r32, cb)); b1 = *reinterpret_cast<const bf16x8*>(Ks + KSWZ(32 + r32, cb)); }
    else { const int cb = ((D0 - 8) * 16 + hi * 8) * 2; b0 = *reinterpret_cast<const bf16x8*>(Krs + KRSWZ(r32, cb)); b1 = *reinterpret_cast<const bf16x8*>(Krs + KRSWZ(32 + r32, cb)); }
    if constexpr (D0 >= NQR) qf = *reinterpret_cast<const bf16x8*>(qrl + (D0 - NQR) * 1024);
}
template <int G, int GS, int NQR> __device__ __forceinline__ void qk_reads(const char* Ks, const char* Krs, const char* qrl, int r32, int hi, bf16x8 (&k)[2 * GS], bf16x8 (&q)[GS]) {
    qk_read1<G * GS, NQR>(Ks, Krs, qrl, r32, hi, k[0], k[1], q[0]);
    if constexpr (GS > 1) qk_read1<G * GS + 1, NQR>(Ks, Krs, qrl, r32, hi, k[2], k[3], q[1]);
}
template <int N> __device__ __forceinline__ void lgkm_wait() {
    static_assert(N >= 0 && N <= 6, "counted LDS wait");
    if constexpr (N == 0) asm volatile("s_waitcnt lgkmcnt(0)" ::: "memory"); else if constexpr (N == 1) asm volatile("s_waitcnt lgkmcnt(1)" ::: "memory");
    else if constexpr (N == 2) asm volatile("s_waitcnt lgkmcnt(2)" ::: "memory"); else if constexpr (N == 3) asm volatile("s_waitcnt lgkmcnt(3)" ::: "memory");
    else if constexpr (N == 4) asm volatile("s_waitcnt lgkmcnt(4)" ::: "memory"); else if constexpr (N == 5) asm volatile("s_waitcnt lgkmcnt(5)" ::: "memory");
    else asm volatile("s_waitcnt lgkmcnt(6)" ::: "memory");
}
template <int G, int GS, int NDQ, int NQR> struct QkChain {
    static __device__ __forceinline__ void run(f32x16& p0, f32x16& p1, const char* Ks, const char* Krs, const bf16x8* qr, const char* qrl, int r32, int hi,
                                               bf16x8 (&ck)[2 * GS], bf16x8 (&cq)[GS], bf16x8 (&nk)[2 * GS], bf16x8 (&nq)[GS]) {
        constexpr int NG = NDQ / GS;
        if constexpr (G + 1 < NG) {
            qk_reads<G + 1, GS, NQR>(Ks, Krs, qrl, r32, hi, nk, nq);
            constexpr int D1 = (G + 1) * GS; constexpr int NR = 2 * GS + (D1 >= NQR ? 1 : 0) + ((GS > 1 && D1 + 1 >= NQR) ? 1 : 0);
            lgkm_wait<NR>();
        } else lgkm_wait<0>();
        SBAR();
#pragma unroll
        for (int s_ = 0; s_ < GS; ++s_) { const int d0 = G * GS + s_; const bf16x8 qf = d0 < NQR ? qr[d0 < NQR ? d0 : 0] : cq[s_];
            p0 = __builtin_amdgcn_mfma_f32_32x32x16_bf16(ck[2 * s_], qf, p0, 0, 0, 0);
            p1 = __builtin_amdgcn_mfma_f32_32x32x16_bf16(ck[2 * s_ + 1], qf, p1, 0, 0, 0); }
        if constexpr (G + 1 < NG) QkChain<G + 1, GS, NDQ, NQR>::run(p0, p1, Ks, Krs, qr, qrl, r32, hi, nk, nq, ck, cq);
    }
};
template <int NDQ, int NQR>
__device__ __forceinline__ void qkt4_seq(f32x16& p0, f32x16& p1, const char* Ks, const char* Krs, const bf16x8* qr, const char* qrl, int r32, int hi) {
    p0 = f32x16{}; p1 = f32x16{};
#pragma unroll
    for (int d0 = 0; d0 < NDQ; ++d0) {
        bf16x8 b0, b1;
        if (d0 < 8) { const int cb = (d0 * 16 + hi * 8) * 2; b0 = *reinterpret_cast<const bf16x8*>(Ks + KSWZ(r32, cb)); b1 = *reinterpret_cast<const bf16x8*>(Ks + KSWZ(32 + r32, cb)); }
        else { const int cb = ((d0 - 8) * 16 + hi * 8) * 2; b0 = *reinterpret_cast<const bf16x8*>(Krs + KRSWZ(r32, cb)); b1 = *reinterpret_cast<const bf16x8*>(Krs + KRSWZ(32 + r32, cb)); }
        bf16x8 qf; if (d0 < NQR) qf = qr[d0]; else qf = *reinterpret_cast<const bf16x8*>(qrl + (d0 - NQR) * 1024);
        p0 = __builtin_amdgcn_mfma_f32_32x32x16_bf16(b0, qf, p0, 0, 0, 0);
        p1 = __builtin_amdgcn_mfma_f32_32x32x16_bf16(b1, qf, p1, 0, 0, 0); }
}
template <int NDQ, int NQR, int GS = 2>
__device__ __forceinline__ void qkt4(f32x16& p0, f32x16& p1, const char* Ks, const char* Krs, const bf16x8* qr, const char* qrl, int r32, int hi) {
    if constexpr (GS == 0) qkt4_seq<NDQ, NQR>(p0, p1, Ks, Krs, qr, qrl, r32, hi);
    else {
        static_assert(GS == 0 || NDQ % (GS ? GS : 1) == 0, "k-steps per group");
        constexpr int GS1 = GS ? GS : 1;
        p0 = f32x16{}; p1 = f32x16{};
        bf16x8 ka[2 * GS1], qa[GS1], kb[2 * GS1], qb[GS1];
        qk_reads<0, GS1, NQR>(Ks, Krs, qrl, r32, hi, ka, qa);
        QkChain<0, GS1, NDQ, NQR>::run(p0, p1, Ks, Krs, qr, qrl, r32, hi, ka, qa, kb, qb);
    }
}
template <int D0, int NDV, int GS, int NQR> struct PvChainQ {
    static __device__ __forceinline__ void run(f32x16* o, int vb, bf16x8 pa0, bf16x8 pa1, bf16x8 pa2, bf16x8 pa3, s16x4 (&cur)[8], s16x4 (&nxt)[8],
                                               const char* Ks, const char* Krs, const char* qrl, int r32, int hi, bf16x8 (&ka)[2 * GS], bf16x8 (&qa)[GS]) {
        if constexpr (D0 + 1 < NDV) { pv_reads4<D0 + 1, NDV>(vb, nxt); asm volatile("s_waitcnt lgkmcnt(8)" ::: "memory"); }
        else { qk_reads<0, GS, NQR>(Ks, Krs, qrl, r32, hi, ka, qa); lgkm_wait<2 * GS + (0 >= NQR ? 1 : 0) + ((GS > 1 && 1 >= NQR) ? 1 : 0)>(); }
        SBAR(); pv_mma(o[D0], cur, pa0, pa1, pa2, pa3);
        if constexpr (D0 + 1 < NDV) PvChainQ<D0 + 1, NDV, GS, NQR>::run(o, vb, pa0, pa1, pa2, pa3, nxt, cur, Ks, Krs, qrl, r32, hi, ka, qa);
    }
};
template <int NDQ, int NQR, int NDV, int GS>
__device__ __forceinline__ void pvqk4(f32x16* o, int vb, bf16x8 pa0, bf16x8 pa1, bf16x8 pa2, bf16x8 pa3, f32x16& p0, f32x16& p1, const char* Ks, const char* Krs, const bf16x8* qr, const char* qrl, int r32, int hi) {
    if constexpr (GS == 0 || NDV > 8) { pv_pipe4<NDV>(o, vb, pa0, pa1, pa2, pa3); qkt4<NDQ, NQR, GS>(p0, p1, Ks, Krs, qr, qrl, r32, hi); }
    else {
        constexpr int GS1 = GS ? GS : 1;
        s16x4 ta[8], tb[8]; bf16x8 ka[2 * GS1], qa[GS1], kb[2 * GS1], qb[GS1];
        pv_reads4<0, NDV>(vb, ta);
        PvChainQ<0, NDV, GS1, NQR>::run(o, vb, pa0, pa1, pa2, pa3, ta, tb, Ks, Krs, qrl, r32, hi, ka, qa);
        p0 = f32x16{}; p1 = f32x16{};
        QkChain<0, GS1, NDQ, NQR>::run(p0, p1, Ks, Krs, qr, qrl, r32, hi, ka, qa, kb, qb);
    }
}
template <int NDQ, int NQR, int NDV>
__device__ __forceinline__ void attn_body4(int wv, const bf16* __restrict__ Qb, int ldq, const bf16* __restrict__ Kn, int ldk, const bf16* __restrict__ Kr,
                                           const bf16* __restrict__ V, int ldv, bf16* __restrict__ Ob, int ocol,
                                           int cbase, int lbase, int nct, int NT, float C, float thr, char* lds,
                                           int comb = 0, float lam = 0.f, float post = 0.f, const float* subg = nullptr) {
    static_assert(NQR <= 8 && NQR <= NDQ, "query fragments: NQR in registers, NDQ - NQR in the wave's LDS words");
    constexpr int SHMV = NDV * 4096, TPR = NDV * 4, RPP = 512 / TPR, NP = 64 / RPP, OFF_WS = 2 * SHMV + SHM_K + (NDQ > 8 ? SHM_KR : 0), QLB = (NDQ - NQR) * 1024;
    const int tid = tid_fresh(wv), wid = tid >> 6, lane = tid & 63, r32 = lane & 31, hi = lane >> 5;
    const bool lead = wid < 4;
    char* V_lds = lds; char* K_lds = lds + 2 * SHMV; char* Kr_lds = lds + 2 * SHMV + SHM_K;
    float* wsf = (float*)(lds + OFF_WS) + wid * 64; float* li_l = wsf; float* al_l = wsf + 32;
    float m_reg = -1e30f, l_reg = 0; f32x16 o[NDV]; bf16x8 qr[NQR];
#pragma unroll
    for (int d = 0; d < NDV; ++d) o[d] = f32x16{};
    const bf16* Qw = Qb + (size_t)(wid * 32 + r32) * ldq + hi * 8;
#pragma unroll
    for (int d0 = 0; d0 < NQR; ++d0) qr[d0] = *reinterpret_cast<const bf16x8*>(Qw + d0 * 16);
    char* qrl = lds + OFF_WS + 2048 + wid * QLB + lane * 16;
    if constexpr (NDQ > NQR) {
#pragma unroll
        for (int d0 = NQR; d0 < NDQ; ++d0) *reinterpret_cast<bf16x8*>(qrl + (d0 - NQR) * 1024) = *reinterpret_cast<const bf16x8*>(Qw + d0 * 16);
        asm volatile("s_waitcnt lgkmcnt(0)" ::: "memory");
    }
    const int ksr = tid >> 4, ksc = (tid & 15) * 8;
    const int vsr = tid / TPR, vsc = (tid % TPR) * 8;
    const int rr = tid >> 3, rc = (tid & 7) * 8;
    const int vb0 = (int)(uintptr_t)V_lds + v_rd_base(lane);
    bf16x8 svs[NP], sks0, sks1, skr;
#define KROW4(j) ((j) < nct ? cbase + (j) * KVBLK : lbase + ((j) - nct) * KVBLK)
#define SLOAD4(j) do { const int k0_ = KROW4(j); _Pragma("unroll") for (int p_ = 0; p_ < NP; ++p_) svs[p_] = *reinterpret_cast<const bf16x8*>(&V[(size_t)(k0_ + vsr + RPP * p_) * ldv + vsc]); \
    sks0 = *reinterpret_cast<const bf16x8*>(&Kn[(size_t)(k0_ + ksr) * ldk + ksc]); sks1 = *reinterpret_cast<const bf16x8*>(&Kn[(size_t)(k0_ + 32 + ksr) * ldk + ksc]); \
    if constexpr (NDQ > 8) skr = *reinterpret_cast<const bf16x8*>(&Kr[(size_t)(k0_ + rr) * 64 + rc]); } while (0)
#define SWRITE4(b) do { _Pragma("unroll") for (int p_ = 0; p_ < NP; ++p_) *(bf16x8*)(V_lds + (b) * SHMV + v_st4<NDV>(vsr + RPP * p_, vsc)) = svs[p_]; const int kc = ksc * 2; \
    *(bf16x8*)(K_lds + KSWZ(ksr, kc)) = sks0; *(bf16x8*)(K_lds + KSWZ(32 + ksr, kc)) = sks1; \
    if constexpr (NDQ > 8) *(bf16x8*)(Kr_lds + KRSWZ(rr, rc * 2)) = skr; } while (0)
#define RESC4(a) do { if (__any((a) < 1.f)) { if (hi == 0) al_l[r32] = (a); asm volatile("s_waitcnt lgkmcnt(0)" ::: "memory"); \
    _Pragma("unroll") for (int d = 0; d < NDV; ++d) _Pragma("unroll") for (int r = 0; r < 16; ++r) o[d][r] *= al_l[crow(r, hi)]; } } while (0)
    f32x16 S0, S1; float alpha = 1.f; bf16x8 pa0, pa1, pa2, pa3;
    SLOAD4(0); asm volatile("s_waitcnt vmcnt(0)" ::: "memory"); SWRITE4(0); __syncthreads();
    if (1 < NT) SLOAD4(1);
    SBAR(); qkt4<NDQ, NQR, (NDV >= 8 ? 0 : 2)>(S0, S1, K_lds, Kr_lds, qr, qrl, r32, hi); SBAR();
    if (lead) { softmax_tile(S0, S1, m_reg, l_reg, alpha, C, thr, pa0, pa1, pa2, pa3); }
    __syncthreads(); asm volatile("s_waitcnt vmcnt(0)" ::: "memory"); if (1 < NT) SWRITE4(1); __syncthreads();
    for (int j = 1; j < NT; ++j) {
        const int b = j & 1;
        if (j + 1 < NT) SLOAD4(j + 1);
        const char* Kb = K_lds; const char* Krb = Kr_lds; const int vbp = vb0 + (b ^ 1) * SHMV;
        if (lead) {
            SBAR(); pvqk4<NDQ, NQR, NDV, (NDV >= 8 ? 0 : 2)>(o, vbp, pa0, pa1, pa2, pa3, S0, S1, Kb, Krb, qr, qrl, r32, hi); SBAR();
            softmax_tile(S0, S1, m_reg, l_reg, alpha, C, thr, pa0, pa1, pa2, pa3); RESC4(alpha); SBAR();
        } else {
            SBAR(); softmax_tile(S0, S1, m_reg, l_reg, alpha, C, thr, pa0, pa1, pa2, pa3); RESC4(alpha); SBAR();
            pvqk4<NDQ, NQR, NDV, (NDV >= 8 ? 0 : 2)>(o, vbp, pa0, pa1, pa2, pa3, S0, S1, Kb, Krb, qr, qrl, r32, hi); SBAR();
        }
        __syncthreads(); asm volatile("s_waitcnt vmcnt(0)" ::: "memory"); if (j + 1 < NT) SWRITE4(b ^ 1); __syncthreads();
    }
    if (!lead) { softmax_tile(S0, S1, m_reg, l_reg, alpha, C, thr, pa0, pa1, pa2, pa3); RESC4(alpha); }
    SBAR(); pv_pipe4<NDV>(o, vb0 + ((NT - 1) & 1) * SHMV, pa0, pa1, pa2, pa3);
    if (hi == 0) li_l[r32] = l_reg; asm volatile("s_waitcnt lgkmcnt(0)" ::: "memory");
    float rli[16];
#pragma unroll
    for (int r = 0; r < 16; ++r) rli[r] = __builtin_amdgcn_rcpf(li_l[crow(r, hi)]);
    __syncthreads();
    { constexpr int OP = NDV * 64 + 16, CPR = NDV * 4;
      char* ost = lds + wid * (32 * OP);
#pragma unroll
      for (int r = 0; r < 16; ++r) { const int orow = crow(r, hi);
#pragma unroll
          for (int d0 = 0; d0 < NDV; ++d0) *(bf16*)(ost + orow * OP + (d0 * 32 + r32) * 2) = f2bf(o[d0][r] * rli[r]); }
      asm volatile("s_waitcnt lgkmcnt(0)" ::: "memory");
      const int tid_e = tid_fresh(wv), wid_e = tid_e >> 6, lane_e = tid_e & 63, hi_e = lane_e >> 5;
      bool plain = true;
      if constexpr (NDV == 8) {
          if (comb) { plain = false;
              const int chunk = lane_e & 31;
              const f32x4 g0 = ((const f32x4*)subg)[2 * chunk], g1 = ((const f32x4*)subg)[2 * chunk + 1];
              u64 q0[16][2];
#pragma unroll
              for (int i = 0; i < 16; ++i) { const u64* p = (const u64*)(Ob + pg8::aimg_off(wid_e * 32 + 2 * i + hi_e, ocol + chunk * 8));
                  q0[i][0] = __hip_atomic_load(p, __ATOMIC_RELAXED, __HIP_MEMORY_SCOPE_AGENT); q0[i][1] = __hip_atomic_load(p + 1, __ATOMIC_RELAXED, __HIP_MEMORY_SCOPE_AGENT); }
#pragma unroll
              for (int i = 0; i < 16; ++i) {
                  const u32x4 v1 = *(const u32x4*)(ost + (2 * i + hi_e) * OP + chunk * 16);
                  const unsigned a0 = (unsigned)q0[i][0], a1 = (unsigned)(q0[i][0] >> 32), a2 = (unsigned)q0[i][1], a3 = (unsigned)(q0[i][1] >> 32);
                  f32x4 d0, d1;
                  d0[0] = __uint_as_float(a0 << 16) - lam * __uint_as_float(v1.x << 16); d0[1] = __uint_as_float(a0 & 0xffff0000u) - lam * __uint_as_float(v1.x & 0xffff0000u);
                  d0[2] = __uint_as_float(a1 << 16) - lam * __uint_as_float(v1.y << 16); d0[3] = __uint_as_float(a1 & 0xffff0000u) - lam * __uint_as_float(v1.y & 0xffff0000u);
                  d1[0] = __uint_as_float(a2 << 16) - lam * __uint_as_float(v1.z << 16); d1[1] = __uint_as_float(a2 & 0xffff0000u) - lam * __uint_as_float(v1.z & 0xffff0000u);
                  d1[2] = __uint_as_float(a3 << 16) - lam * __uint_as_float(v1.w << 16); d1[3] = __uint_as_float(a3 & 0xffff0000u) - lam * __uint_as_float(v1.w & 0xffff0000u);
                  const float ss = half_sum(((d0[0] * d0[0] + d0[1] * d0[1]) + (d0[2] * d0[2] + d0[3] * d0[3])) + ((d1[0] * d1[0] + d1[1] * d1[1]) + (d1[2] * d1[2] + d1[3] * d1[3])));
                  const float rstd = post / sqrtf(ss * (1.0f / 256.0f) + 1e-5f);
                  const f32x4 y0 = d0 * rstd * g0, y1 = d1 * rstd * g1;
                  u32x4 w; w.x = cvt_pk_bf16(y0[0], y0[1]); w.y = cvt_pk_bf16(y0[2], y0[3]); w.z = cvt_pk_bf16(y1[0], y1[1]); w.w = cvt_pk_bf16(y1[2], y1[3]);
                  *(u32x4*)(Ob + pg8::aimg_off(wid_e * 32 + 2 * i + hi_e, ocol + chunk * 8)) = w;
              }
          }
      }
      if (plain) {
#pragma unroll
      for (int i = 0; i < 32 * CPR / 64; ++i) { const int idx = lane_e + 64 * i, row = idx / CPR, chunk = idx % CPR;
          const u32x4 v = *(const u32x4*)(ost + row * OP + chunk * 16);
          *(u32x4*)(Ob + pg8::aimg_off(wid_e * 32 + row, ocol + chunk * 8)) = v; } } }
    __syncthreads();
#undef KROW4
#undef SLOAD4
#undef SWRITE4
#undef RESC4
}
__device__ __forceinline__ void attn_mla(int wv, const bf16* Q, const bf16* KV, const bf16* KR, bf16* AO, int need_ctx) {
    extern __shared__ __attribute__((aligned(16))) unsigned char lds[];
    const int G = gridDim.x, bx = blockIdx.x; const int vcu = (G % 8 == 0) ? (bx % 8) * (G / 8) + bx / 8 : bx;
    const float scale = 0.07216878364870322f;
    const float C = scale * 1.4426950408889634f, thr = 8.f / scale;
    const int NUL = NBATCH * 16 * 8, NUC = need_ctx ? NBATCH * 16 : 0;
    for (int u = vcu; u < NUL + NUC; u += G) {
        int b, h, qrow, nct, NT;
        if (u < NUL) { const int bh = u >> 3, qb = u & 7; b = bh >> 4; h = bh & 15; qrow = TC + b * SEQ + qb * 256; nct = 4; NT = 36; }
        else { const int bh = u - NUL; b = bh >> 4; h = bh & 15; qrow = b * CTXL; nct = 4; NT = 4; }
        attn_body4<12, 8, 4>(wv, Q + (size_t)qrow * 3072 + h * 192, 3072, KV + h * 256, 4096, KR, KV + h * 256 + 128, 4096, AO + (size_t)qrow * DM, h * 128,
                      b * CTXL, TC + b * SEQ, nct, NT, C, thr, (char*)lds);
    }
}
__device__ __forceinline__ void attn_diff(int wv, const bf16* QKV, bf16* OD, const float* lambdas, const float* subg, float lambda_init, int need_ctx) {
    extern __shared__ __attribute__((aligned(16))) unsigned char lds[];
    const int G = gridDim.x, bx = blockIdx.x; const int vcu = (G % 8 == 0) ? (bx % 8) * (G / 8) + bx / 8 : bx;
    const float scale = 0.08838834764831845f;
    const float C = scale * 1.4426950408889634f, thr = 8.f / scale;
    const int lane = tid_fresh(wv) & 63;
    const float la = lambdas[lane] * lambdas[128 + lane] + lambdas[64 + lane] * lambdas[192 + lane];
    const float lb = lambdas[256 + lane] * lambdas[384 + lane] + lambdas[320 + lane] * lambdas[448 + lane];
    const float lam = expf(wave_sum(la)) - expf(wave_sum(lb)) + lambda_init;
    const float post = 1.0f - lambda_init;
    const int NUL = NBATCH * 8 * 8, NUC = need_ctx ? NBATCH * 8 : 0;
    for (int u = vcu; u < NUL + NUC; u += G) {
        int b, h, qrow, NT;
        if (u < NUL) { const int bh = u >> 3, qb = u & 7; b = bh >> 3; h = bh & 7; qrow = TC + b * SEQ + qb * 256; NT = 36; }
        else { const int bh = u - NUL; b = bh >> 3; h = bh & 7; qrow = b * CTXL; NT = 4; }
        for (int c = 0; c < 2; ++c) {
            const int vh = 2 * h + c;
            attn_body4<8, 1, 8>(wv, QKV + (size_t)qrow * 6144 + vh * 128, 6144, QKV + 2048 + vh * 128, 6144, nullptr, QKV + 4096 + h * 256, 6144,
                                OD + (size_t)qrow * DM, h * 256, b * CTXL, TC + b * SEQ, 4, NT, C, thr, (char*)lds, c, lam, post, subg);
        }
    }
}

__device__ __forceinline__ void final_norm_phase(int wv, float* out, const float* gvec) {
    const int tid_ = tid_fresh(wv); const int lane = tid_ & 63, wave = tid_ >> 6; const int gw = blockIdx.x * NWAVES + wave, NGW = gridDim.x * NWAVES;
    f32x4 g[8];
#pragma unroll
    for (int j = 0; j < 8; ++j) g[j] = ((const f32x4*)gvec + lane)[64 * j];
    f32x4 nv[8], nv2[8];
    if (gw < TL) { const int r2 = gw + NGW < TL ? gw + NGW : gw; const f32x4* a = (const f32x4*)(out + (size_t)gw * DM) + lane; const f32x4* c = (const f32x4*)(out + (size_t)r2 * DM) + lane;
#pragma unroll
        for (int j = 0; j < 8; ++j) { nv[j] = a[64 * j]; nv2[j] = c[64 * j]; } }
    for (int row = gw; row < TL; row += 2 * NGW) {
        const int row2 = row + NGW < TL ? row + NGW : row;
        f32x4* xr = (f32x4*)(out + (size_t)row * DM) + lane; f32x4* xr2 = (f32x4*)(out + (size_t)row2 * DM) + lane;
        f32x4 v[8], v2[8]; float s = 0.f, s2 = 0.f;
#pragma unroll
        for (int j = 0; j < 8; ++j) { v[j] = nv[j]; v2[j] = nv2[j]; }
        { const int rn = row + 2 * NGW; if (rn < TL) { const int rn2 = rn + NGW < TL ? rn + NGW : rn; const f32x4* a = (const f32x4*)(out + (size_t)rn * DM) + lane; const f32x4* c = (const f32x4*)(out + (size_t)rn2 * DM) + lane;
#pragma unroll
            for (int j = 0; j < 8; ++j) { nv[j] = a[64 * j]; nv2[j] = c[64 * j]; } } }
#pragma unroll
        for (int j = 0; j < 8; ++j) { s += (v[j].x * v[j].x + v[j].y * v[j].y) + (v[j].z * v[j].z + v[j].w * v[j].w); s2 += (v2[j].x * v2[j].x + v2[j].y * v2[j].y) + (v2[j].z * v2[j].z + v2[j].w * v2[j].w); }
        const float rstd = 1.0f / sqrtf(wave_sum(s) * (1.0f / DM) + 1e-6f), rstd2 = 1.0f / sqrtf(wave_sum(s2) * (1.0f / DM) + 1e-6f);
#pragma unroll
        for (int j = 0; j < 8; ++j) { xr[64 * j] = v[j] * rstd * g[j]; if (row2 != row) xr2[64 * j] = v2[j] * rstd2 * g[j]; }
    }
}
__device__ __forceinline__ void gate_load(const bf16* Z, int tb_lo, int NTB_C, int un, int trow, int chunk, u32x4 (&vm)[3], u32x4 (&vc)[3], u32x4 (&vp)[3]) {
    const int tb = tb_lo + un / 32, c0 = (un % 32) * 64;
    int t0, L, rbase;
    if (tb < NTB_C) { t0 = (tb & 3) * 64; L = CTXL; rbase = (tb >> 2) * CTXL; } else { const int q = tb - NTB_C; t0 = (q & 31) * 64; L = SEQ; rbase = TC + (q >> 5) * SEQ; }
    const int t = t0 + trow;
#pragma unroll
    for (int p = 1; p < 3; ++p) {
        const bf16* zp = Z + (size_t)(rbase + t) * 6144 + p * DM + c0 + chunk * 8;
        vm[p] = (u32x4){0u, 0u, 0u, 0u}; vp[p] = (u32x4){0u, 0u, 0u, 0u};
        vc[p] = *(const u32x4*)zp;
        if (t > 0) vm[p] = *(const u32x4*)(zp - 6144);
        if (t < L - 1) vp[p] = *(const u32x4*)(zp + 6144);
    }
}
__device__ __forceinline__ void hy_gate_phase(int wv, const bf16* Z, bf16* Gt, const float* cw, const float* cb, int need_ctx) {
    extern __shared__ __attribute__((aligned(16))) unsigned char lds[];
    LAS bf16* gl0 = (LAS bf16*)lds;
    const int tid = tid_fresh(wv), trow = tid >> 3, chunk = tid & 7;
    const int NTB_C = NBATCH * (CTXL / 64), NTB = NTB_C + NBATCH * (SEQ / 64);
    int par = 0;
    const int tb_lo = need_ctx ? 0 : NTB_C;
    const int NU = (NTB - tb_lo) * 32;
    int cblk_cur = -1;
    float w0[3][8], w1[3][8], w2[3][8], bb[3][8];
    u32x4 nm[3], nc[3], np[3];
    if ((int)blockIdx.x < NU) gate_load(Z, tb_lo, NTB_C, blockIdx.x, trow, chunk, nm, nc, np);
    for (int u = blockIdx.x; u < NU; u += gridDim.x) {
        const int tb = tb_lo + u / 32, cblk = u % 32, c0 = cblk * 64;
        if (cblk != cblk_cur) {
            cblk_cur = cblk;
#pragma unroll
            for (int p = 1; p < 3; ++p) { const int col = p * DM + c0 + chunk * 8;
#pragma unroll
                for (int h = 0; h < 2; ++h) { const f32x4 a0 = *(const f32x4*)(cw + col + 4 * h), a1 = *(const f32x4*)(cw + 6144 + col + 4 * h), a2 = *(const f32x4*)(cw + 2 * 6144 + col + 4 * h), a3 = *(const f32x4*)(cb + col + 4 * h);
#pragma unroll
                    for (int e = 0; e < 4; ++e) { w0[p][4 * h + e] = a0[e]; w1[p][4 * h + e] = a1[e]; w2[p][4 * h + e] = a2[e]; bb[p][4 * h + e] = a3[e]; } } }
        }
        int b, t0, L, rbase; bf16* gdst;
        if (tb < NTB_C) { b = tb >> 2; t0 = (tb & 3) * 64; L = CTXL; rbase = b * CTXL; gdst = Gt + (size_t)DM * NBATCH * SEQ + ((size_t)c0 * NBATCH + b) * CTXL + t0; }
        else { const int q = tb - NTB_C; b = q >> 5; t0 = (q & 31) * 64; L = SEQ; rbase = TC + b * SEQ; gdst = Gt + ((size_t)c0 * NBATCH + b) * SEQ + t0; }
        const int t = t0 + trow; const size_t row = (size_t)(rbase + t);
        u32x4 cm[3], cc[3], cp[3];
#pragma unroll
        for (int p = 1; p < 3; ++p) { cm[p] = nm[p]; cc[p] = nc[p]; cp[p] = np[p]; }
        { const int un = u + gridDim.x; if (un < NU) gate_load(Z, tb_lo, NTB_C, un, trow, chunk, nm, nc, np); }
        float zc[3][8];
#pragma unroll
        for (int p = 1; p < 3; ++p) {
            const u32x4 vm = cm[p], v0 = cc[p], vp = cp[p];
#pragma unroll
            for (int e = 0; e < 4; ++e) {
                const float m0 = __uint_as_float(vm[e] << 16), m1 = __uint_as_float(vm[e] & 0xffff0000u);
                const float c0f = __uint_as_float(v0[e] << 16), c1f = __uint_as_float(v0[e] & 0xffff0000u);
                const float p0 = __uint_as_float(vp[e] << 16), p1 = __uint_as_float(vp[e] & 0xffff0000u);
                zc[p][2 * e] = w0[p][2 * e] * m0 + w1[p][2 * e] * c0f + w2[p][2 * e] * p0 + bb[p][2 * e];
                zc[p][2 * e + 1] = w0[p][2 * e + 1] * m1 + w1[p][2 * e + 1] * c1f + w2[p][2 * e + 1] * p1 + bb[p][2 * e + 1];
            }
        }
        LAS bf16* gl = gl0 + par * (64 * 72); par ^= 1;
#pragma unroll
        for (int e = 0; e < 8; ++e) gl[(chunk * 8 + e) * 72 + trow] = f2bf(zc[2][e] * zc[1][e]);
        __syncthreads();
        { const int c = tid >> 3;
          const u32x4 v = *(const LAS u32x4*)(gl + c * 72 + chunk * 8);
          *(u32x4*)(gdst + (size_t)c * NBATCH * L + chunk * 8) = v; }
    }
    __syncthreads();
}
__device__ __forceinline__ void mul_load(const bf16* Yt, const bf16* Z, int tb_lo, int NTB_C, int un, int tid, u32x4& yv, u32x4& xm, u32x4& xc, u32x4& xp) {
    const int trow = tid >> 3, chunk = tid & 7, c = tid >> 3;
    const int tb = tb_lo + un / 32, c0 = (un % 32) * 64;
    int b, t0, L, rbase; const bf16* src;
    if (tb < NTB_C) { b = tb >> 2; t0 = (tb & 3) * 64; L = CTXL; rbase = b * CTXL; src = Yt + (size_t)DM * NBATCH * SEQ + ((size_t)c0 * NBATCH + b) * CTXL + t0; }
    else { const int q = tb - NTB_C; b = q >> 5; t0 = (q & 31) * 64; L = SEQ; rbase = TC + b * SEQ; src = Yt + ((size_t)c0 * NBATCH + b) * SEQ + t0; }
    yv = *(const u32x4*)(src + (size_t)c * NBATCH * L + chunk * 8);
    const int t = t0 + trow; const bf16* zp = Z + (size_t)(rbase + t) * 6144 + c0 + chunk * 8;
    xm = (u32x4){0u, 0u, 0u, 0u}; xp = (u32x4){0u, 0u, 0u, 0u};
    xc = *(const u32x4*)zp;
    if (t > 0) xm = *(const u32x4*)(zp - 6144);
    if (t < L - 1) xp = *(const u32x4*)(zp + 6144);
}
__device__ __forceinline__ void hy_mul_phase(int wv, const bf16* Yt, const bf16* Z, bf16* Y, const float* cw, const float* cb, int need_ctx) {
    extern __shared__ __attribute__((aligned(16))) unsigned char lds[];
    LAS bf16* gl0 = (LAS bf16*)lds;
    const int tid = tid_fresh(wv), trow = tid >> 3, chunk = tid & 7;
    const int NTB_C = NBATCH * (CTXL / 64), NTB = NTB_C + NBATCH * (SEQ / 64);
    const int tb_lo = need_ctx ? 0 : NTB_C;
    const int NU = (NTB - tb_lo) * 32;
    int cblk_cur = -1, par = 0;
    float w0[8], w1[8], w2[8], bb[8];
    u32x4 ny, nm, nc, np;
    if ((int)blockIdx.x < NU) mul_load(Yt, Z, tb_lo, NTB_C, blockIdx.x, tid, ny, nm, nc, np);
    for (int u = blockIdx.x; u < NU; u += gridDim.x) {
        const int tb = tb_lo + u / 32, cblk = u % 32, c0 = cblk * 64;
        if (cblk != cblk_cur) {
            cblk_cur = cblk;
            const int col = c0 + chunk * 8;
#pragma unroll
            for (int h = 0; h < 2; ++h) { const f32x4 a0 = *(const f32x4*)(cw + col + 4 * h), a1 = *(const f32x4*)(cw + 6144 + col + 4 * h), a2 = *(const f32x4*)(cw + 2 * 6144 + col + 4 * h), a3 = *(const f32x4*)(cb + col + 4 * h);
#pragma unroll
                for (int e = 0; e < 4; ++e) { w0[4 * h + e] = a0[e]; w1[4 * h + e] = a1[e]; w2[4 * h + e] = a2[e]; bb[4 * h + e] = a3[e]; } }
        }
        int t0, rbase;
        if (tb < NTB_C) { t0 = (tb & 3) * 64; rbase = (tb >> 2) * CTXL; } else { const int q = tb - NTB_C; t0 = (q & 31) * 64; rbase = TC + (q >> 5) * SEQ; }
        const u32x4 yv = ny, vm = nm, v0 = nc, vp = np;
        { const int un = u + gridDim.x; if (un < NU) mul_load(Yt, Z, tb_lo, NTB_C, un, tid, ny, nm, nc, np); }
        LAS bf16* gl = gl0 + par * (64 * 72); par ^= 1;
        { const int c = tid >> 3; *(LAS u32x4*)(gl + c * 72 + chunk * 8) = yv; }
        const size_t oy = (size_t)((rbase + t0 + trow) & ~255) * DM + pg8::aimg_off((t0 + trow) & 255, c0 + chunk * 8);
        float x0[8];
#pragma unroll
        for (int e = 0; e < 4; ++e) {
            const float m0 = __uint_as_float(vm[e] << 16), m1 = __uint_as_float(vm[e] & 0xffff0000u);
            const float c0f = __uint_as_float(v0[e] << 16), c1f = __uint_as_float(v0[e] & 0xffff0000u);
            const float p0 = __uint_as_float(vp[e] << 16), p1 = __uint_as_float(vp[e] & 0xffff0000u);
            x0[2 * e] = w0[2 * e] * m0 + w1[2 * e] * c0f + w2[2 * e] * p0 + bb[2 * e];
            x0[2 * e + 1] = w0[2 * e + 1] * m1 + w1[2 * e + 1] * c1f + w2[2 * e + 1] * p1 + bb[2 * e + 1];
        }
        __syncthreads();
        float y[8];
#pragma unroll
        for (int e = 0; e < 8; ++e) y[e] = bf2f(gl[(chunk * 8 + e) * 72 + trow]);
        u32x4 w;
        w.x = cvt_pk_bf16(y[0] * x0[0], y[1] * x0[1]); w.y = cvt_pk_bf16(y[2] * x0[2], y[3] * x0[3]);
        w.z = cvt_pk_bf16(y[4] * x0[4], y[5] * x0[5]); w.w = cvt_pk_bf16(y[6] * x0[6], y[7] * x0[7]);
        *(u32x4*)(Y + oy) = w;
    }
    __syncthreads();
}
template <int LF>
__device__ __forceinline__ void conv_wave(LAS const unsigned char* gl, LAS const unsigned char* rkl, int tw0, float fb, bf16* ydst  , int lane) {
    constexpr int GP = (LF + 8) * 2, RP = (2 * LF + 16) * 2, NS = LF / 32;
    const int i = lane & 15, q = lane >> 4, a = i & 7, ih = i - a;
    f32x4 acc[16];
#pragma unroll
    for (int m = 0; m < 16; ++m) acc[m] = (f32x4){0.f, 0.f, 0.f, 0.f};
    const LAS unsigned char* gb = gl + i * GP + q * 16;
    const LAS unsigned char* rb = rkl + a * RP + (LF - tw0 - 240 + 8 * q - ih) * 2;
    bf16x8 F[16];
#pragma unroll
    for (int m = 0; m < 16; ++m) F[m] = *(const LAS bf16x8*)(rb + (15 - m) * 32);
    bf16x8 B = *(const LAS bf16x8*)gb;
    for (int n8 = 0; n8 < NS; n8 += 8) {
#pragma unroll
        for (int r = 0; r < 8; ++r) {
            const int n = n8 + r;
            const bf16x8 nA0 = *(const LAS bf16x8*)(rb + (15 + 2 * n + 2) * 32), nA1 = *(const LAS bf16x8*)(rb + (15 + 2 * n + 1) * 32);
            const bf16x8 nB = *(const LAS bf16x8*)(gb + (n + 1) * 64);
#pragma unroll
            for (int m = 0; m < 16; ++m) acc[m] = __builtin_amdgcn_mfma_f32_16x16x32_bf16(F[(m - 2 * r) & 15], B, acc[m], 0, 0, 0);
            F[(14 - 2 * r) & 15] = nA0; F[(15 - 2 * r) & 15] = nA1; B = nB;
        }
    }
#pragma unroll
    for (int m = 0; m < 16; ++m) {
        const int t = tw0 + 16 * m + 4 * q;
        const u32x2 gw = *(const LAS u32x2*)(gl + i * GP + t * 2);
        const float g0 = __uint_as_float(gw.x << 16), g1 = __uint_as_float(gw.x & 0xffff0000u), g2 = __uint_as_float(gw.y << 16), g3 = __uint_as_float(gw.y & 0xffff0000u);
        u32x2 w; w.x = cvt_pk_bf16(acc[m][0] + g0 * fb, acc[m][1] + g1 * fb); w.y = cvt_pk_bf16(acc[m][2] + g2 * fb, acc[m][3] + g3 * fb);
        *(u32x2*)(ydst + (size_t)i * LF + t) = w;
    }
}
__device__ __forceinline__ void rk_scatter(LAS unsigned char* rkl, int RP, int t, u32x4 w) {
#pragma unroll
    for (int a = 0; a < 8; ++a) {
        LAS unsigned char* p = rkl + a * RP + (8 * t + a) * 2;
        if ((a & 1) == 0) { *(LAS unsigned*)(p) = w.x; *(LAS unsigned*)(p + 4) = w.y; *(LAS unsigned*)(p + 8) = w.z; *(LAS unsigned*)(p + 12) = w.w; }
        else { *(LAS bf16*)(p) = (bf16)(w.x & 0xffffu);
            *(LAS unsigned*)(p + 2) = __builtin_amdgcn_alignbit(w.y, w.x, 16); *(LAS unsigned*)(p + 6) = __builtin_amdgcn_alignbit(w.z, w.y, 16); *(LAS unsigned*)(p + 10) = __builtin_amdgcn_alignbit(w.w, w.z, 16);
            *(LAS bf16*)(p + 14) = (bf16)(w.w >> 16); }
    }
}
__device__ __forceinline__ void hy_conv_phase(int wv, const bf16* Gt, bf16* Yt, const bf16* KFL, const bf16* KFC, const float* fbias, int need_ctx) {
    extern __shared__ __attribute__((aligned(16))) unsigned char lds[];
    const int tid = tid_fresh(wv), lane = tid & 63, wave = tid >> 6;
    {
        constexpr int LF = SEQ, GP = (LF + 8) * 2, RP = (2 * LF + 16) * 2;
        LAS unsigned char* gl = (LAS unsigned char*)lds; LAS unsigned char* rkl = gl + 16 * GP;
        u32x4 gq[8], rq;
        int c = blockIdx.x;
        if (c < DM) {
            const bf16* gsrc = Gt + (size_t)c * NBATCH * LF;
#pragma unroll
            for (int i = 0; i < 8; ++i) gq[i] = *(const u32x4*)(gsrc + (size_t)(tid + i * NTHREADS) * 8);
            rq = *(const u32x4*)(KFL + (size_t)c * (2 * LF) + 8 * tid);
        }
        for (; c < DM; c += gridDim.x) {
#pragma unroll
            for (int i = 0; i < 8; ++i) { const int idx = tid + i * NTHREADS; const int b = idx / (LF / 8), s8 = idx % (LF / 8); *(LAS u32x4*)(gl + b * GP + s8 * 16) = gq[i]; }
            rk_scatter(rkl, RP, tid, rq);
            __syncthreads();
            const int cn = c + gridDim.x;
            if (cn < DM) {
                const bf16* gsrc = Gt + (size_t)cn * NBATCH * LF;
#pragma unroll
                for (int i = 0; i < 8; ++i) gq[i] = *(const u32x4*)(gsrc + (size_t)(tid + i * NTHREADS) * 8);
                rq = *(const u32x4*)(KFL + (size_t)cn * (2 * LF) + 8 * tid);
            }
            conv_wave<LF>(gl, rkl, wave * 256, fbias[c], Yt + (size_t)c * NBATCH * LF, lane);
            __syncthreads();
        }
    }
    if (need_ctx) {
        constexpr int LF = CTXL, GP = (LF + 8) * 2, RP = (2 * LF + 16) * 2;
        LAS unsigned char* gl = (LAS unsigned char*)lds + wave * (16 * GP + 8 * RP); LAS unsigned char* rkl = gl + 16 * GP;
        const bf16* GtC = Gt + (size_t)DM * NBATCH * SEQ; bf16* YtC = Yt + (size_t)DM * NBATCH * SEQ;
        for (int c = blockIdx.x * NWAVES + wave; c < DM; c += gridDim.x * NWAVES) {
            const bf16* gsrc = GtC + (size_t)c * NBATCH * LF;
            u32x4 gq[8];
#pragma unroll
            for (int i = 0; i < 8; ++i) gq[i] = *(const u32x4*)(gsrc + (size_t)(lane + i * 64) * 8);
            const u32x4 rq = *(const u32x4*)(KFC + (size_t)c * (2 * LF) + 8 * lane);
#pragma unroll
            for (int i = 0; i < 8; ++i) { const int idx = lane + i * 64; const int b = idx / (LF / 8), s8 = idx % (LF / 8); *(LAS u32x4*)(gl + b * GP + s8 * 16) = gq[i]; }
            rk_scatter(rkl, RP, lane, rq);
            LDS_WAIT(); asm volatile("" ::: "memory");
            conv_wave<LF>(gl, rkl, 0, fbias[c], YtC + (size_t)c * NBATCH * LF, lane);
            LDS_WAIT(); asm volatile("" ::: "memory");
        }
        __syncthreads();
    }
}

struct Args { const float* in[36]; float* out; unsigned char* ws; int ph_lo, ph_hi; };
__device__ __forceinline__ int rope_src(int j, int R) { const int hR = R >> 1; const int axis = j / hR, jj = j % hR; return axis * hR + (jj & 1) * (R >> 2) + (jj >> 1); }
__device__ __forceinline__ int ti_lanecol(int scol0, int pm, int lane) {
    const int n4 = lane & 7;
    if (pm == 0) return scol0 + 4 * n4;
    const int R = pm == 1 ? 64 : 128, hR = R >> 1, blk = scol0 & ~(R - 1), woff = scol0 & (R - 1), axis = woff / hR, jj0 = woff % hR;
    return blk + axis * hR + (jj0 >> 1) + (n4 >> 2) * (R >> 2) + 4 * (n4 & 3);
}
__device__ __forceinline__ void ti_load(const float* W, int Nsrc, int lanecol, int k0, int lane, f32x4 (&v)[8]) {
    const int kr = lane >> 3;
    const float* wp = W + (size_t)(k0 + kr) * Nsrc + lanecol;
#pragma unroll
    for (int i = 0; i < 8; ++i) v[i] = *(const f32x4*)(wp + (size_t)(8 * i) * Nsrc);
}
__device__ __forceinline__ void ti_store(int K, bf16* WT, int n0, int k0, LAS float* scr, int lane) {
    LDS_WAIT(); asm volatile("" ::: "memory");
    const int c = lane & 7;
#pragma unroll
    for (int j = 0; j < 4; ++j) { const int n = (lane >> 3) + 8 * j; const LAS float* s = scr + (8 * c) * 33 + n;
        u32x4 o; o.x = cvt_pk_bf16(s[0 * 33], s[1 * 33]); o.y = cvt_pk_bf16(s[2 * 33], s[3 * 33]); o.z = cvt_pk_bf16(s[4 * 33], s[5 * 33]); o.w = cvt_pk_bf16(s[6 * 33], s[7 * 33]);
        *(u32x4*)((char*)WT + pg8::wimg_off(n0 + n, k0 + 8 * c, K)) = o; }
    LDS_WAIT(); asm volatile("" ::: "memory");
}
__device__ __forceinline__ void ti_finish(const f32x4 (&v)[8], int K, bf16* WT, int n0, int k0, LAS float* scr, int lane, bool rope = false) {
    const int n4 = lane & 7, kr = lane >> 3;
    const int c0 = rope ? 8 * (n4 & 3) + (n4 >> 2) : 4 * n4, cs = rope ? 2 : 1;
#pragma unroll
    for (int i = 0; i < 8; ++i) { LAS float* d = scr + (kr + 8 * i) * 33 + c0; d[0] = v[i].x; d[cs] = v[i].y; d[2 * cs] = v[i].z; d[3 * cs] = v[i].w; }
    ti_store(K, WT, n0, k0, scr, lane);
}
__device__ __forceinline__ void transpose_item_slow(const float* W, int K, int Nsrc, int scol0, int pm, bf16* WT, int n0, int k0, LAS float* scr, int lane) {
    int sc = -1;
    if (scol0 >= 0) { const int j = lane & 31;
        if (pm == 1) { const int blk = scol0 & ~63, w = (scol0 & 63) + j; sc = blk + rope_src(w, 64); }
        else if (pm == 2) { const int blk = scol0 & ~127, w = (scol0 & 127) + j; sc = blk + rope_src(w, 128); }
        else sc = scol0 + j; }
#pragma unroll 8
    for (int i = 0; i < 32; ++i) { const int kk = 2 * i + (lane >> 5); scr[kk * 33 + (lane & 31)] = sc >= 0 ? W[(size_t)(k0 + kk) * Nsrc + sc] : 0.f; }
    ti_store(K, WT, n0, k0, scr, lane);
}
struct CJ { int src, src2; unsigned src_off, src2_off; int K, Nsrc, Ndst, kind; unsigned long long dst; };
#define WJ(src, soff, K, Ns, Nd, kind, dst) { src, 13, (unsigned)(soff), 0u, K, Ns, Nd, kind, (unsigned long long)(dst) }
__device__ const CJ g_jobs[20] = {
    { 10, 13, 0u, 0u, DM, 768, 1536, 1, WS_W + W_DQKV },
    { 10, 13, (unsigned)(DM * 768), (unsigned)(DM * 576), DM, 768, 1536, 1, WS_W + W_DQKV + (unsigned long long)1536 * DM * 2 },
    WJ(12, 0, 768, 3072, 3072, 2, WS_W + W_UQ), WJ(12, 768 * 3072, 768, 3072, 3072, 2, WS_W + W_UQ + (unsigned long long)3072 * 768 * 2),
    WJ(15, 0, 512, 4096, 4096, 0, WS_W + W_UKV), WJ(15, 512 * 4096, 512, 4096, 4096, 0, WS_W + W_UKV + (unsigned long long)4096 * 512 * 2),
    WJ(16, 0, DM, DM, DM, 0, WS_W + W_WOA), WJ(16, DM * DM, DM, DM, DM, 0, WS_W + W_WOA + (unsigned long long)DM * DM * 2),
    WJ(17, 0, DM, 6144, 6144, 0, WS_W + W_HYIN), WJ(30, 0, DM, DM, DM, 0, WS_W + W_HYOUT),
    WJ(32, 0, DM, 6144, 6144, 3, WS_W + W_DFQKV), WJ(35, 0, DM, DM, DM, 0, WS_W + W_DFWO),
    WJ(7, 0, DM, DFF, DFF, 0, WS_W + W_W1), WJ(7, 1 * DM * DFF, DM, DFF, DFF, 0, WS_W + W_W1 + (unsigned long long)1 * DFF * DM * 2),
    WJ(7, 2 * DM * DFF, DM, DFF, DFF, 0, WS_W + W_W1 + (unsigned long long)2 * DFF * DM * 2), WJ(7, 3 * DM * DFF, DM, DFF, DFF, 0, WS_W + W_W1 + (unsigned long long)3 * DFF * DM * 2),
    WJ(8, 0, DFF, DM, DM, 0, WS_W + W_W2), WJ(8, 1 * DM * DFF, DFF, DM, DM, 0, WS_W + W_W2 + (unsigned long long)1 * DFF * DM * 2),
    WJ(8, 2 * DM * DFF, DFF, DM, DM, 0, WS_W + W_W2 + (unsigned long long)2 * DFF * DM * 2), WJ(8, 3 * DM * DFF, DFF, DM, DM, 0, WS_W + W_W2 + (unsigned long long)3 * DFF * DM * 2),
};
#undef WJ

__device__ __forceinline__ void mod_unit(int wv, unsigned char* ws, int uu) {
    extern __shared__ __attribute__((aligned(16))) unsigned char lds[];
    const int tid = tid_fresh(wv), lane = tid & 63, wave = tid >> 6;
    LAS float* S = (LAS float*)lds;
    const float* cin = in_ptr(1); const float* cctx = in_ptr(3);
    const int layer = uu / 48, cb = (uu % 48) * 256;
    const char* Wl = (const char*)(in_ptr(4) + (size_t)layer * DM * NMOD + cb);
    const unsigned voff = (unsigned)lane * 16u;
    f32x4 acc[17];
#pragma unroll
    for (int b = 0; b < 17; ++b) acc[b] = (f32x4){0.f, 0.f, 0.f, 0.f};
    for (int kc = 0; kc < 2; ++kc) {
        for (int idx = tid; idx < 17 * 1024; idx += NTHREADS) { const int bi = idx >> 10, k = idx & 1023; const float x = bi < 16 ? cin[bi * DM + kc * 1024 + k] : cctx[kc * 1024 + k];
            S[k * 20 + bi] = x * __builtin_amdgcn_rcpf(1.0f + __builtin_amdgcn_exp2f(-1.4426950408889634f * x)); }
        __syncthreads();
        const int kbeg = wave * 128;
#pragma unroll 1
        for (int k8 = kbeg; k8 < kbeg + 128; k8 += 16) {
            f32x4 wq[16];
#pragma unroll
            for (int j = 0; j < 16; ++j) wq[j] = *(const f32x4*)(Wl + (size_t)(kc * 1024 + k8 + j) * (NMOD * 4) + voff);
#pragma unroll
            for (int j = 0; j < 16; ++j) { const int k = k8 + j; const f32x4 w = wq[j];
                const LAS f32x4* sp = (const LAS f32x4*)(S + k * 20);
                const f32x4 s0 = sp[0], s1 = sp[1], s2 = sp[2], s3 = sp[3]; const float s16 = S[k * 20 + 16];
                acc[0] += w * s0.x; acc[1] += w * s0.y; acc[2] += w * s0.z; acc[3] += w * s0.w;
                acc[4] += w * s1.x; acc[5] += w * s1.y; acc[6] += w * s1.z; acc[7] += w * s1.w;
                acc[8] += w * s2.x; acc[9] += w * s2.y; acc[10] += w * s2.z; acc[11] += w * s2.w;
                acc[12] += w * s3.x; acc[13] += w * s3.y; acc[14] += w * s3.z; acc[15] += w * s3.w;
                acc[16] += w * s16; }
        }
        __syncthreads();
    }
    LAS float* P = (LAS float*)lds;
#pragma unroll
    for (int b = 0; b < 17; ++b) *(LAS f32x4*)(P + (wave * 17 + b) * 256 + 4 * lane) = acc[b];
    __syncthreads();
    float* MOD = (float*)(ws + WS_MOD);
    const float* ab = in_ptr(5) + (size_t)layer * NMOD + cb;
    for (int idx = tid; idx < 17 * 256; idx += NTHREADS) { const int bi = idx >> 8, col = idx & 255; float s = ab[col];
#pragma unroll
        for (int w = 0; w < 8; ++w) s += P[(w * 17 + bi) * 256 + col];
        MOD[((size_t)layer * 17 + bi) * NMOD + cb + col] = s; }
    __syncthreads();
}
__device__ __forceinline__ void filter_unit(int wv, unsigned char* ws, int u) {
    extern __shared__ __attribute__((aligned(16))) unsigned char lds[];
    const int tid = tid_fresh(wv);
    LAS float* feats = (LAS float*)lds;
    LAS float* hA = feats + 16 * 36;
    LAS float* hB = hA + 16 * 64;
    LAS float* hT = hB + 16 * 64;
    const float *w1 = in_ptr(21), *b1 = in_ptr(22), *w2 = in_ptr(23), *b2 = in_ptr(24), *w3 = in_ptr(25), *b3 = in_ptr(26), *fr = in_ptr(27), *wout = in_ptr(28);
    const int Lf = u < 128 ? SEQ : CTXL; const int i0 = (u < 128 ? u : u - 128) * 16;
    bf16* KF = u < 128 ? (bf16*)(ws + WS_KFL) : (bf16*)(ws + WS_KFC);
    const float invLm1 = 1.0f / (float)(Lf - 1), invL = 1.0f / (float)Lf;
    for (int idx = tid; idx < 16 * 33; idx += NTHREADS) { const int r = idx / 33, e = idx % 33; const int i = i0 + r;
        float v;
        if (e == 0) v = (float)i * invLm1;
        else { const int j = (e - 1) & 15; const float f = 1e-4f + (float)j * ((15.0f - 1e-4f) / 15.0f);
            float turns = f * ((float)i * invL); turns -= floorf(turns);
            v = (e <= 16) ? __builtin_amdgcn_cosf(turns) : -__builtin_amdgcn_sinf(turns); }
        feats[r * 36 + e] = v; }
    __syncthreads();
    for (int idx = tid; idx < 16 * 64; idx += NTHREADS) { const int r = idx >> 6, o = idx & 63; float s = b1[o];
        for (int e = 0; e < 33; ++e) s += feats[r * 36 + e] * w1[e * 64 + o];
        hA[r * 64 + o] = sinf(fr[o] * s); }
    __syncthreads();
    for (int idx = tid; idx < 16 * 64; idx += NTHREADS) { const int r = idx >> 6, o = idx & 63; float s = b2[o];
        for (int e = 0; e < 64; ++e) s += hA[r * 64 + e] * w2[e * 64 + o];
        hB[r * 64 + o] = sinf(fr[64 + o] * s); }
    __syncthreads();
    for (int idx = tid; idx < 16 * 64; idx += NTHREADS) { const int r = idx >> 6, o = idx & 63; float s = b3[o];
        for (int e = 0; e < 64; ++e) s += hB[r * 64 + e] * w3[e * 64 + o];
        hT[o * 16 + r] = sinf(fr[128 + o] * s); }
    __syncthreads();
#pragma unroll 1
    for (int pp = 0; pp < 4; ++pp) {
        const int pass = pp >> 1, rh = (pp & 1) * 8;
        const int j0 = pass * 2048 + tid * 4;
        f32x4 acc[8];
#pragma unroll
        for (int r = 0; r < 8; ++r) acc[r] = (f32x4){0.f, 0.f, 0.f, 0.f};
#pragma unroll 1
        for (int k16 = 0; k16 < 64; k16 += 16) {
            f32x4 wq[16];
#pragma unroll
            for (int j = 0; j < 16; ++j) wq[j] = *(const f32x4*)(wout + (size_t)(k16 + j) * 4096 + j0);
#pragma unroll
            for (int j = 0; j < 16; ++j) { const f32x4 w = wq[j];
                const LAS f32x4* hp = (const LAS f32x4*)(hT + (k16 + j) * 16 + rh);
                const f32x4 h0 = hp[0], h1 = hp[1];
                acc[0] += w * h0.x; acc[1] += w * h0.y; acc[2] += w * h0.z; acc[3] += w * h0.w;
                acc[4] += w * h1.x; acc[5] += w * h1.y; acc[6] += w * h1.z; acc[7] += w * h1.w; }
        }
#pragma unroll
        for (int e = 0; e < 4; ++e) {
            const int c = (j0 & 2047) + e;
            const float dl2 = -1.4426950408889634f * (3.0701134573253945f + (float)c * (12.280453829301578f / 2047.0f));
            bf16* kf = KF + (size_t)c * (2 * Lf);
#pragma unroll
            for (int r = 0; r < 8; ++r) { const int i = i0 + rh + r; const float tt = (float)i * invLm1;
                const float v = acc[r][e] * __builtin_amdgcn_exp2f(tt * dl2);
                if (pass == 0) kf[Lf - i] = f2bf(v);
                else { if (i > 0) kf[Lf + i] = f2bf(v); else kf[0] = 0; } }
        }
    }
    __syncthreads();
}
__device__ __forceinline__ void prologue_phase(int wv, unsigned char* ws) {
    extern __shared__ __attribute__((aligned(16))) unsigned char lds[];
    if (gridDim.x >= 256) {
        for (int rep = 0; rep < (PROBE_DUP == 10 ? 2 : 1); ++rep) {
        if (blockIdx.x < 192) mod_unit(wv, ws, blockIdx.x);
        else { for (int u = blockIdx.x - 192; u < 144; u += gridDim.x - 192) filter_unit(wv, ws, u); }
        }
    } else {
        for (int uu = blockIdx.x; uu < 192; uu += gridDim.x) mod_unit(wv, ws, uu);
        for (int u = blockIdx.x; u < 144; u += gridDim.x) filter_unit(wv, ws, u);
    }
    const int tid = tid_fresh(wv), lane = tid & 63, wave = tid >> 6;
    {
        f32x2* tabA = (f32x2*)(ws + WS_TAB); f32x2* tabD = (f32x2*)(ws + WS_TAB + 16384);
        for (int idx = blockIdx.x * NTHREADS + tid; idx < 64 * 16 + 64 * 32; idx += gridDim.x * NTHREADS) {
            int p, f; float nf; f32x2* dst;
            if (idx < 1024) { p = idx >> 4; f = idx & 15; nf = 1.0f / 16.0f; dst = tabA + idx; } else { const int q = idx - 1024; p = q >> 5; f = q & 31; nf = 1.0f / 32.0f; dst = tabD + q; }
            const float invf = __builtin_amdgcn_exp2f(-(float)f * nf * 13.287712379549449f);
            float turns = (float)p * invf * 0.15915494309189535f; turns -= floorf(turns);
            *dst = (f32x2){__builtin_amdgcn_cosf(turns), __builtin_amdgcn_sinf(turns)};
        }
    }
    {
        LAS float* scr = (LAS float*)(lds + wave * 16384);
        LAS unsigned* tick = (LAS unsigned*)(lds + 8 * 16384);
        unsigned* ctr = (unsigned*)(ws + WS_CTL) + 2048;
        constexpr int JP[21] = {0, 1536, 3072, 4224, 5376, 6400, 7424, 9472, 11520, 17664, 19712, 25856, 27904, 36096, 44288, 52480, 60672, 68864, 77056, 85248, 93440};
        constexpr int total = JP[20];
        f32x4 pv[8]; int pn0 = 0, pk0 = 0, pK = 0; bf16* pdst = nullptr; bool have = false, prope = false;
        for (;;) {
            __syncthreads();
            if (tid == 0) *tick = __hip_atomic_fetch_add(ctr, 64u, __ATOMIC_RELAXED, __HIP_MEMORY_SCOPE_AGENT);
            __syncthreads();
            const int base = __builtin_amdgcn_readfirstlane((int)*tick);
            if (base >= total) break;
            const int it0 = base + wv * 8; if (it0 >= total) continue;
            int jb = 0, joff = 0;
#pragma unroll
            for (int k = 1; k < 20; ++k) { const bool ge = it0 >= JP[k]; jb += ge ? 1 : 0; joff = ge ? JP[k] : joff; }
            const CJ J = g_jobs[jb];
            const float* src = in_ptr(J.src) + J.src_off; const float* src2 = in_ptr(J.src2) + J.src2_off;
            bf16* dst = (bf16*)(ws + J.dst);
            const int K = J.K, nnb = J.Ndst / 32;
            const int itj = it0 - joff; const int nb0 = itj % nnb, kb = itj / nnb; const int k0 = kb * 64;
#pragma unroll 1
            for (int q = 0; q < 8; ++q) {
                const int n0 = (nb0 + q) * 32;
                const float* W = src; int ns = J.Nsrc, scol0 = n0, pm = 0;
                if (J.kind == 1) {
                    if (n0 < 768) { } else if (n0 < 1344) { W = src2; ns = 576; scol0 = n0 - 768; pm = (scol0 >= 512) ? 1 : 0; } else scol0 = -1;
                } else if (J.kind == 2) { pm = ((n0 % 192) >= 128) ? 1 : 0; }
                else if (J.kind == 3) { pm = (n0 < 4096) ? 2 : 0; }
                if (scol0 >= 0) {
                    f32x4 cv[8]; ti_load(W, ns, ti_lanecol(scol0, pm, lane), k0, lane, cv);
                    if (have) ti_finish(pv, pK, pdst, pn0, pk0, scr, lane, prope);
#pragma unroll
                    for (int i = 0; i < 8; ++i) pv[i] = cv[i];
                    pn0 = n0; pk0 = k0; pK = K; pdst = dst; prope = pm != 0; have = true;
                } else {
                    if (have) { ti_finish(pv, pK, pdst, pn0, pk0, scr, lane, prope); have = false; }
                    transpose_item_slow(W, K, ns, scol0, pm, dst, n0, k0, scr, lane);
                }
            }
        }
        if (have) ti_finish(pv, pK, pdst, pn0, pk0, scr, lane, prope);
    }
    __syncthreads();
}

struct SJ { int layer, chunk; unsigned long long w; int N; unsigned off; };
__device__ const SJ g_shw[8] = {
    {0, 0, WS_W + W_DQKV, 1536, 0u}, {0, 3, WS_W + W_W1, 8192, 26112u}, {1, 0, WS_W + W_HYIN, 6144, 165376u}, {1, 3, WS_W + W_W1 + (unsigned long long)1 * DFF * DM * 2, 8192, 269824u},
    {2, 0, WS_W + W_DFQKV, 6144, 409088u}, {2, 3, WS_W + W_W1 + (unsigned long long)2 * DFF * DM * 2, 8192, 513536u},
    {3, 0, WS_W + W_DQKV + (unsigned long long)1536 * DM * 2, 1536, 652800u}, {3, 3, WS_W + W_W1 + (unsigned long long)3 * DFF * DM * 2, 8192, 678912u} };
__device__ __forceinline__ void prep_phase(int wv, unsigned char* ws) {
    extern __shared__ __attribute__((aligned(16))) unsigned char lds[];
    const int tid = tid_fresh(wv), lane = tid & 63, wave = tid >> 6; const int gw = blockIdx.x * NWAVES + wave, NGW = gridDim.x * NWAVES;
    const float* MOD = (const float*)(ws + WS_MOD);
    {
        float* GC = (float*)(ws + WS_GC); const float* ng = in_ptr(6);
        for (int idx = blockIdx.x * NTHREADS + tid; idx < 8 * 17 * 512; idx += gridDim.x * NTHREADS) { const int c4 = idx & 511, r = idx >> 9, bi = r % 17, lw = r / 17, l = lw >> 1, w = lw & 1;
            const f32x4 g = ((const f32x4*)(ng + (size_t)lw * DM))[c4], sc = ((const f32x4*)(MOD + ((size_t)l * 17 + bi) * NMOD + (w ? 4 : 1) * DM))[c4];
            ((f32x4*)(GC + ((size_t)lw * 17 + bi) * DM))[c4] = g * (sc + 1.0f); }
    }
    {
        bf16* XG = (bf16*)(ws + WS_R + R_XGB); u64* SSQ0 = (u64*)(ws + WS_SSQ);
        const float* ng = in_ptr(6); const float* xs = in_ptr(0); const float* cs = in_ptr(2);
        const f32x4* gp = (const f32x4*)ng + lane;
        f32x4 vn[8], vm[8];
        if (gw < TT) { const f32x4* xr = (const f32x4*)(gw < TC ? cs + (size_t)gw * DM : xs + (size_t)(gw - TC) * DM) + lane;
#pragma unroll
            for (int j = 0; j < 8; ++j) vn[j] = xr[64 * j]; }
        if (gw + NGW < TT) { const int r1 = gw + NGW; const f32x4* xr = (const f32x4*)(r1 < TC ? cs + (size_t)r1 * DM : xs + (size_t)(r1 - TC) * DM) + lane;
#pragma unroll
            for (int j = 0; j < 8; ++j) vm[j] = xr[64 * j]; }
        for (int row = gw; row < TT; row += NGW) {
            const int bi = bi_of(row);
            const f32x4* scp = (const f32x4*)(MOD + (size_t)bi * NMOD + DM) + lane;
            f32x4 v[8]; float sq = 0.f;
#pragma unroll
            for (int j = 0; j < 8; ++j) { v[j] = vn[j]; vn[j] = vm[j]; }
            { const int rn = row + 2 * NGW; if (rn < TT) { const f32x4* xr = (const f32x4*)(rn < TC ? cs + (size_t)rn * DM : xs + (size_t)(rn - TC) * DM) + lane;
#pragma unroll
                for (int j = 0; j < 8; ++j) vm[j] = xr[64 * j]; } }
#pragma unroll
            for (int j = 0; j < 8; ++j) sq += (v[j].x * v[j].x + v[j].y * v[j].y) + (v[j].z * v[j].z + v[j].w * v[j].w);
            sq = wave_sum(sq);
            if (lane == 0) SSQ0[row] = (u64)__float2ll_rn(sq * 1048576.0f);
            bf16* xo = XG + (size_t)(row >> 8) * (BM * DM) + pg8::aimg_off(row & 255, 4 * lane);
#pragma unroll
            for (int j = 0; j < 8; ++j) { const f32x4 y = v[j] * gp[64 * j] * (scp[64 * j] + 1.0f);
                u32x2 w; w.x = cvt_pk_bf16(y.x, y.y); w.y = cvt_pk_bf16(y.z, y.w); *(u32x2*)(xo + (size_t)(4 * j) * (BM * 64)) = w; }
        }
    }
    {
        LAS float* S = (LAS float*)lds;
        const bool dealt = gridDim.x == 256;
        int ci_lo = 0, ci_hi = 8, wrank = gw, wcount = NGW;
        if (dealt) { const int bx = blockIdx.x; const int ci = bx < 8 ? 0 : bx < 52 ? 1 : bx < 85 ? 2 : bx < 128 ? 3 : bx < 161 ? 4 : bx < 205 ? 5 : bx < 213 ? 6 : 7;
            const int base = ci == 0 ? 0 : ci == 1 ? 8 : ci == 2 ? 52 : ci == 3 ? 85 : ci == 4 ? 128 : ci == 5 ? 161 : ci == 6 ? 205 : 213;
            const int cnt = (ci == 0 || ci == 6) ? 8 : (ci == 2 || ci == 4) ? 33 : (ci == 1 || ci == 5) ? 44 : 43;
            ci_lo = ci; ci_hi = ci + 1; wrank = (bx - base) * NWAVES + wave; wcount = cnt * NWAVES; }
#pragma unroll 1
        for (int ci = ci_lo; ci < ci_hi; ++ci) {
            const SJ J = g_shw[ci];
            __syncthreads();
            for (int idx = tid; idx < 17 * 512; idx += NTHREADS) { const int bi = idx >> 9, c4 = idx & 511;
                ((LAS f32x4*)S)[idx] = ((const f32x4*)(MOD + ((size_t)J.layer * 17 + bi) * NMOD + J.chunk * DM))[c4]; }
            __syncthreads();
            const bf16* W = (const bf16*)(ws + J.w); float* out = (float*)(ws + WS_SHW) + J.off;
#pragma unroll 1
            for (int n = wrank * 2; n < J.N; n += wcount * 2) {
                float a0[17], a1[17];
#pragma unroll
                for (int b = 0; b < 17; ++b) { a0[b] = 0.f; a1[b] = 0.f; }
#pragma unroll 1
                for (int j = 0; j < 4; ++j) {
                    const u32x4 p0 = *(const u32x4*)((const char*)W + pg8::wimg_off(n, 8 * lane + 512 * j, DM)), p1 = *(const u32x4*)((const char*)W + pg8::wimg_off(n + 1, 8 * lane + 512 * j, DM));
                    float x0[8], x1[8];
#pragma unroll
                    for (int e = 0; e < 4; ++e) { x0[2 * e] = __uint_as_float(p0[e] << 16); x0[2 * e + 1] = __uint_as_float(p0[e] & 0xffff0000u); x1[2 * e] = __uint_as_float(p1[e] << 16); x1[2 * e + 1] = __uint_as_float(p1[e] & 0xffff0000u); }
#pragma unroll
                    for (int b = 0; b < 17; ++b) { const LAS f32x4* sp = (const LAS f32x4*)(S + b * DM + 8 * lane + 512 * j); const f32x4 s0 = sp[0], s1 = sp[1];
                        a0[b] += (x0[0] * s0.x + x0[1] * s0.y) + (x0[2] * s0.z + x0[3] * s0.w) + (x0[4] * s1.x + x0[5] * s1.y) + (x0[6] * s1.z + x0[7] * s1.w);
                        a1[b] += (x1[0] * s0.x + x1[1] * s0.y) + (x1[2] * s0.z + x1[3] * s0.w) + (x1[4] * s1.x + x1[5] * s1.y) + (x1[6] * s1.z + x1[7] * s1.w);
                        if ((b & 3) == 3) asm volatile("" ::: "memory"); }
                }
#pragma unroll
                for (int b = 0; b < 17; ++b) { const float r0 = wave_sum(a0[b]), r1 = wave_sum(a1[b]); if (lane == 0) { out[(size_t)b * J.N + n] = r0; out[(size_t)b * J.N + n + 1] = r1; } }
            }
        }
        __syncthreads();
    }
}

__global__ void __launch_bounds__(NTHREADS, 2) mega_fwd(Args args) {
    extern __shared__ __attribute__((aligned(16))) unsigned char lds[];
    volatile LAS unsigned* MISC = (volatile LAS unsigned*)((LAS unsigned char*)lds + MISC_OFF);
    if (threadIdx.x < 32) MISC[threadIdx.x] = 0u;
    __syncthreads();
    unsigned char* const ws0 = args.ws;
    const int wv = __builtin_amdgcn_readfirstlane(threadIdx.x >> 6);
    XcdBarrier bar = xcd_barrier_post((unsigned*)(ws0 + WS_CTL) + CW_BAR, MISC + 8);
    const int lo = args.ph_lo, hi = args.ph_hi;
    int ph = 0;
#define IN_PH() (lo <= ph && ph < hi)
#define END_PH() do { if (lo <= ph && ph + 1 < hi) xcd_barrier(bar.bar, bar.x, bar.st, tid_fresh(wv) == 0, gridDim.x); ++ph; } while (0)
#define WSP(T, off) ((T*)(ws + (off)))

    if (IN_PH()) { for (int rep = 0; rep < (PROBE_DUP == 4 ? 2 : 1); ++rep) prologue_phase(wv, fresh(ws0)); }
    END_PH();
    if (IN_PH()) prep_phase(wv, fresh(ws0));
    END_PH();

#define RP(T, off) ((T*)(ws + WS_R + (off)))
#define SSQP(nid) ((u64*)(ws + WS_SSQ) + (size_t)(nid) * TT)
#define SHWP(ci) ((const float*)(ws + WS_SHW) + g_shw[ci].off)
#define GCP(lw) ((const float*)(ws + WS_GC) + (size_t)(lw) * 17 * DM)
    for (int layer = 0; layer < 4; ++layer) {
        const int need_ctx = layer < 3;
        const int row_lo = need_ctx ? 0 : TC;
        const int Mres = TT - row_lo;
        const size_t modoff = WS_MOD + (size_t)layer * 17 * NMOD * 4;
        const Pre nopre{nullptr, nullptr, 0, 0, 0.f};
        constexpr float INV_D = 1.0f / (1048576.0f * DM);
        if (layer == 0 || layer == 3) {
            const int j = layer == 0 ? 0 : 1;
            constexpr size_t O_DQKV = 144 * MiB, O_Q = 144 * MiB, O_CQN = 0, O_CKVN = 54 * MiB, O_KR = 360 * MiB, O_KV = 365 * MiB, O_AO = 0;
            if (IN_PH()) { unsigned char* ws = fresh(ws0); gemm_dqkv(wv, RP(bf16, R_XGB), WSP(bf16, WS_W + W_DQKV) + (size_t)j * 1536 * DM, RP(bf16, O_CQN), RP(bf16, O_CKVN), RP(bf16, O_KR), in_ptr(11) + j * 768, in_ptr(14) + j * 512, WSP(f32x2, WS_TAB),
                                                               Pre{SSQP(2 * layer), SHWP(layer == 0 ? 0 : 6), 1536, 0, INV_D}, SSQP(9 + 2 * j), SSQP(10 + 2 * j)); }
            END_PH();
            if (IN_PH()) {
                { unsigned char* ws = fresh(ws0); gemm_rope(wv, RP(bf16, O_CQN) + (size_t)row_lo * 768, WSP(bf16, WS_W + W_UQ) + (size_t)j * 3072 * 768, Mres, 3072, 768, RP(bf16, O_Q) + (size_t)row_lo * 3072, 3072, WSP(f32x2, WS_TAB), 1, Pre{SSQP(9 + 2 * j), nullptr, 0, row_lo, 1.0f / (1048576.0f * 768.0f)}, 1); }
                { unsigned char* ws = fresh(ws0); gemm_bf16(wv, RP(bf16, O_CKVN), WSP(bf16, WS_W + W_UKV) + (size_t)j * 4096 * 512, TT, 4096, 512, RP(bf16, O_KV), 4096, nullptr, 0, Pre{SSQP(10 + 2 * j), nullptr, 0, 0, 1.0f / (1048576.0f * 512.0f)}, 0, 1); }
            }
            END_PH();
            if (IN_PH()) { for (int rep = 0; rep < (PROBE_DUP == 2 ? 2 : 1); ++rep) { unsigned char* ws = fresh(ws0); attn_mla(wv, RP(bf16, O_Q), RP(bf16, O_KV), RP(bf16, O_KR), RP(bf16, O_AO), need_ctx); } }
            END_PH();
            if (IN_PH()) { unsigned char* ws = fresh(ws0); gemm_resid(wv, RP(bf16, O_AO) + (size_t)row_lo * DM, WSP(bf16, WS_W + W_WOA) + (size_t)j * DM * DM, Mres, DM, DM, WSP(bf16, WS_H), nullptr, WSP(float, modoff) + 2 * DM, row_lo, RP(bf16, R_XGB), GCP(layer * 2 + 1), SSQP(2 * layer + 1), layer == 0 ? in_ptr(0) : nullptr, layer == 0 ? in_ptr(2) : nullptr, nullptr, 1); }
            END_PH();
        } else if (layer == 1) {
            constexpr size_t O_Z = 0, O_YT = 432 * MiB, O_GT = 600 * MiB;
            bf16* const Yp = (bf16*)(fresh(ws0) + WS_H + 144 * MiB);
            if (IN_PH()) { unsigned char* ws = fresh(ws0); gemm_bf16(wv, RP(bf16, R_XGB), WSP(bf16, WS_W + W_HYIN), TT, 6144, DM, RP(bf16, O_Z), 6144, in_ptr(18), 0, Pre{SSQP(2), SHWP(2), 6144, 0, INV_D}, 0, 1); }
            END_PH();
            if (IN_PH()) { for (int rep = 0; rep < (PROBE_DUP == 6 ? 2 : 1); ++rep) { unsigned char* ws = fresh(ws0); hy_gate_phase(wv, RP(bf16, O_Z), RP(bf16, O_GT), in_ptr(19), in_ptr(20), need_ctx); } }
            END_PH();
            if (IN_PH()) { for (int rep = 0; rep < (PROBE_DUP == 6 ? 2 : 1); ++rep) { unsigned char* ws = fresh(ws0); hy_conv_phase(wv, RP(bf16, O_GT), RP(bf16, O_YT), WSP(bf16, WS_KFL), WSP(bf16, WS_KFC), in_ptr(29), need_ctx); } }
            END_PH();
            if (IN_PH()) { for (int rep = 0; rep < (PROBE_DUP == 6 ? 2 : 1); ++rep) { unsigned char* ws = fresh(ws0); hy_mul_phase(wv, RP(bf16, O_YT), RP(bf16, O_Z), Yp, in_ptr(19), in_ptr(20), need_ctx); } }
            END_PH();
            if (IN_PH()) { unsigned char* ws = fresh(ws0); gemm_resid(wv, Yp + (size_t)row_lo * DM, WSP(bf16, WS_W + W_HYOUT), Mres, DM, DM, WSP(bf16, WS_H), in_ptr(31), WSP(float, modoff) + 2 * DM, row_lo, RP(bf16, R_XGB), GCP(layer * 2 + 1), SSQP(2 * layer + 1), nullptr, nullptr, nullptr, 1); }
            END_PH();
        } else {
            constexpr size_t O_QKV = 0, O_OD0 = 432 * MiB;
            const float lambda_init = 0.8f - 0.6f * 0.5488116360940264f;
            if (IN_PH()) { unsigned char* ws = fresh(ws0); gemm_rope(wv, RP(bf16, R_XGB), WSP(bf16, WS_W + W_DFQKV), TT, 6144, DM, RP(bf16, O_QKV), 6144, WSP(f32x2, WS_TAB + 16384), 2, Pre{SSQP(4), SHWP(4), 6144, 0, INV_D}, 1); }
            END_PH();
            if (IN_PH()) { for (int rep = 0; rep < (PROBE_DUP == 3 ? 2 : 1); ++rep) { unsigned char* ws = fresh(ws0); attn_diff(wv, RP(bf16, O_QKV), RP(bf16, O_OD0), in_ptr(33), in_ptr(34), lambda_init, need_ctx); } }
            END_PH();
            if (IN_PH()) { unsigned char* ws = fresh(ws0); gemm_resid(wv, RP(bf16, O_OD0) + (size_t)row_lo * DM, WSP(bf16, WS_W + W_DFWO), Mres, DM, DM, WSP(bf16, WS_H), nullptr, WSP(float, modoff) + 2 * DM, row_lo, RP(bf16, R_XGB), GCP(layer * 2 + 1), SSQP(2 * layer + 1), layer == 0 ? in_ptr(0) : nullptr, layer == 0 ? in_ptr(2) : nullptr, nullptr, 1); }
            END_PH();
        }
        if (IN_PH()) { for (int rep = 0; rep < (PROBE_DUP == 1 ? 2 : 1); ++rep) { unsigned char* ws = fresh(ws0); gemm_bf16(wv, RP(bf16, R_XGB) + (size_t)row_lo * DM, WSP(bf16, WS_W + W_W1) + (size_t)layer * DFF * DM, Mres, DFF, DM, RP(bf16, 0) + (size_t)row_lo * DFF, DFF, nullptr, 1, Pre{SSQP(2 * layer + 1), SHWP(2 * layer + 1), DFF, row_lo, INV_D}, 1, 1); } }
        END_PH();
        if (IN_PH() && PROBE_DUP == 9) { unsigned char* ws = fresh(ws0); gemm_bf16(wv, RP(bf16, 0) + (size_t)row_lo * DFF, WSP(bf16, WS_W + W_W2) + (size_t)layer * DM * DFF, Mres, DM, DFF, RP(bf16, R_XGB) + (size_t)row_lo * DM, DM, nullptr, 0, nopre); }
        if (IN_PH()) { unsigned char* ws = fresh(ws0); gemm_resid(wv, RP(bf16, 0) + (size_t)row_lo * DFF, WSP(bf16, WS_W + W_W2) + (size_t)layer * DM * DFF, Mres, DM, DFF, WSP(bf16, WS_H), nullptr, WSP(float, modoff) + 5 * DM, row_lo,
                                                               layer < 3 ? RP(bf16, R_XGB) : nullptr, layer < 3 ? GCP(layer * 2 + 2) : nullptr, layer < 3 ? SSQP(2 * layer + 2) : nullptr, nullptr, nullptr, layer == 3 ? args.out : nullptr, 1); }
        END_PH();
    }
    if (IN_PH()) { unsigned char* ws = fresh(ws0); final_norm_phase(wv, args.out, in_ptr(9)); }
}

#ifndef PROBE_DUP
#define PROBE_DUP 0
#endif
#ifndef MK_SPLIT
#define MK_SPLIT 0
#endif
constexpr int N_PHASES = 2 + 4 * 2 + (4 + 5 + 3 + 4) + 1;
extern "C" void kernel_launch(void* const* d_in, const int* in_sizes, int n_in, void* d_out, int out_size, void* d_ws, size_t ws_size, hipStream_t stream) {
    static int grid = 0;
    if (grid == 0) {
        if (n_in != 36 || out_size != TL * DM || ws_size < WS_END) { fprintf(stderr, "kernel_launch: unexpected shapes: n_in %d out %d ws %zu (need %zu)\n", n_in, out_size, ws_size, (size_t)WS_END); grid = -1; return; }
        int dev = 0, cus = 0, per_cu = 0;
        if (hipGetDevice(&dev) != hipSuccess || hipDeviceGetAttribute(&cus, hipDeviceAttributeMultiprocessorCount, dev) != hipSuccess) { grid = -1; return; }
        if (hipFuncSetAttribute((const void*)mega_fwd, hipFuncAttributeMaxDynamicSharedMemorySize, LDS_BYTES) != hipSuccess) { fprintf(stderr, "kernel_launch: hipFuncSetAttribute failed\n"); grid = -1; return; }
        if (hipOccupancyMaxActiveBlocksPerMultiprocessor(&per_cu, (const void*)mega_fwd, NTHREADS, LDS_BYTES) != hipSuccess || per_cu < 1) { fprintf(stderr, "kernel_launch: occupancy query says %d\n", per_cu); (void)hipGetLastError(); }
        grid = cus;
    }
    if (grid < 0) return;
    (void)hipMemsetAsync((char*)d_ws + WS_CTL, 0, CTL_ZERO_BYTES, stream);
    Args a; memset(&a, 0, sizeof(a));
    for (int i = 0; i < 36; ++i) a.in[i] = (const float*)d_in[i];
    a.out = (float*)d_out; a.ws = (unsigned char*)d_ws;
#if MK_SPLIT
    for (int p = 0; p < N_PHASES; ++p) { a.ph_lo = p; a.ph_hi = p + 1; hipLaunchKernelGGL(mega_fwd, dim3(grid), dim3(NTHREADS), LDS_BYTES, stream, a); }
#else
    a.ph_lo = 0; a.ph_hi = N_PHASES;
    hipLaunchKernelGGL(mega_fwd, dim3(grid), dim3(NTHREADS), LDS_BYTES, stream, a);
#endif
    const hipError_t le = hipPeekAtLastError();
    if (le != hipSuccess) fprintf(stderr, "kernel_launch: launch failed: %s\n", hipGetErrorName(le));
}
```

```cpp
#include <hip/hip_runtime.h>
#include <cstdio>
#include <cstdint>
#include <cstring>

#define GAS __attribute__((address_space(1)))
#define LAS __attribute__((address_space(3)))
typedef unsigned short bf16;
typedef short bf16x8 __attribute__((ext_vector_type(8)));
typedef short s16x4 __attribute__((ext_vector_type(4)));
typedef float f32x4 __attribute__((ext_vector_type(4)));
typedef float f32x2 __attribute__((ext_vector_type(2)));
typedef float f32x16 __attribute__((ext_vector_type(16)));
typedef unsigned u32x4 __attribute__((ext_vector_type(4)));
typedef unsigned u32x2 __attribute__((ext_vector_type(2)));

#ifndef PROBE_DUP
#define PROBE_DUP 0
#endif
constexpr int DM = 2048, NBATCH = 16, SEQ = 2048, CTXL = 256, DFF = 8192;
constexpr int TC = NBATCH * CTXL, TL = NBATCH * SEQ, TT = TC + TL;
constexpr int NMOD = 6 * DM;
constexpr int NWAVES = 8, NTHREADS = 512;
constexpr int LDS_BYTES = 147456;
constexpr int MISC_OFF = LDS_BYTES - 256;

constexpr size_t MiB = 1u << 20;
constexpr size_t WS_CTL = 0, CTL_ZERO_BYTES = 4 * MiB;
constexpr size_t WS_SSQ = 64 * 1024;
constexpr size_t WS_TAB = 4 * MiB;
constexpr size_t WS_MOD = 4 * MiB + 65536;
constexpr size_t WS_GC = 8 * MiB;
constexpr size_t WS_SHW = 10 * MiB;
constexpr size_t WS_KFL = 14 * MiB;
constexpr size_t WS_KFC = 30 * MiB;
constexpr size_t WS_W = 32 * MiB;
constexpr size_t W_DQKV = 0, W_UQ = 12 * MiB, W_UKV = 21 * MiB, W_WOA = 29 * MiB, W_HYIN = 45 * MiB, W_HYOUT = 69 * MiB,
                 W_DFQKV = 77 * MiB, W_DFWO = 101 * MiB, W_W1 = 109 * MiB, W_W2 = 237 * MiB, W_END = 365 * MiB;
constexpr size_t WS_H = WS_W + W_END;
constexpr size_t WS_R = WS_H + 288 * MiB;
constexpr size_t R_XGB = 600 * MiB;
constexpr size_t WS_END = WS_R + 744 * MiB;
constexpr int CW_BAR = 4096;

__device__ __forceinline__ unsigned cvt_pk_bf16(float lo, float hi) { unsigned r; asm volatile("v_cvt_pk_bf16_f32 %0, %1, %2" : "=v"(r) : "v"(lo), "v"(hi)); return r; }
__device__ __forceinline__ float bf2f(unsigned short b) { return __uint_as_float(((unsigned)b) << 16); }
__device__ __forceinline__ unsigned short f2bf(float f) { return (unsigned short)(cvt_pk_bf16(f, 0.f) & 0xffffu); }
template <int CTRL> __device__ __forceinline__ float dpp_mov(float v) { return __builtin_bit_cast(float, __builtin_amdgcn_update_dpp(0, __builtin_bit_cast(int, v), CTRL, 0xf, 0xf, true)); }
__device__ __forceinline__ float rows_sum(float v) {
    auto a = __builtin_amdgcn_permlane16_swap(__float_as_uint(v), __float_as_uint(v), false, false); v = __uint_as_float(a[0]) + __uint_as_float(a[1]);
    auto b = __builtin_amdgcn_permlane32_swap(__float_as_uint(v), __float_as_uint(v), false, false); return __uint_as_float(b[0]) + __uint_as_float(b[1]);
}
__device__ __forceinline__ float wave_sum(float v) {
    v += dpp_mov<0xB1>(v);
    v += dpp_mov<0x4E>(v);
    v += dpp_mov<0x141>(v);
    v += dpp_mov<0x140>(v);
    return rows_sum(v);
}
__device__ __forceinline__ float half_sum(float v) {
    v += dpp_mov<0xB1>(v); v += dpp_mov<0x4E>(v); v += dpp_mov<0x141>(v); v += dpp_mov<0x140>(v);
    auto a = __builtin_amdgcn_permlane16_swap(__float_as_uint(v), __float_as_uint(v), false, false); return __uint_as_float(a[0]) + __uint_as_float(a[1]);
}
__device__ __forceinline__ int tid_fresh(int wv) { unsigned m = ~0u; asm volatile("" : "+s"(m)); int t = (wv << 6) | (int)__builtin_amdgcn_mbcnt_hi(m, __builtin_amdgcn_mbcnt_lo(m, 0u)); asm volatile("" : "+v"(t)); return t; }
template <class T> __device__ __forceinline__ T* fresh(T* p) { GAS T* g = (GAS T*)p; asm volatile("" : "+s"(g)); return (T*)g; }
__device__ __forceinline__ const float* in_ptr(int i) {
    auto ka = __builtin_amdgcn_kernarg_segment_ptr(); int ii = i; asm volatile("" : "+s"(ii));
    const GAS float* p = ((const GAS float* const __attribute__((address_space(4)))*)ka)[ii]; return (const float*)p; }
#define LDS_WAIT() asm volatile("s_waitcnt lgkmcnt(0)" ::: "memory")
#define VM_WAIT() asm volatile("s_waitcnt vmcnt(0)" ::: "memory")

#define XB_TMO      128
#define XB_XCNT(j)  (256  + 64 * (j))
#define XB_XSUB(j)  (1280 + 64 * (j))
#define XB_XGEN(j)  (2304 + 64 * (j))
#define XB_TOP      3328
#define XB_TOPGEN   3392
#define XCD_BAR_WORDS 3456
#define XB_SPIN_CAP (1u << 20)
__device__ __forceinline__ unsigned xb_ld(unsigned* p)              { return __hip_atomic_load(p, __ATOMIC_RELAXED, __HIP_MEMORY_SCOPE_AGENT); }
__device__ __forceinline__ unsigned xb_add(unsigned* p, unsigned v) { return __hip_atomic_fetch_add(p, v, __ATOMIC_RELAXED, __HIP_MEMORY_SCOPE_AGENT); }
__device__ __forceinline__ unsigned xb_xcc_id() { return (unsigned)__builtin_amdgcn_s_getreg((3 << 11) | 20) & 0xFu; }
#define XB_SPIN(cond, bar) do { unsigned _sp = 0; while (cond) { __builtin_amdgcn_s_sleep(1); \
    if ((++_sp & 255u) == 0u) { if (xb_ld(&(bar)[XB_TMO])) break; if (_sp > XB_SPIN_CAP) { atomicAdd(&(bar)[XB_TMO], 1u); break; } } } } while (0)
struct XcdBarrier { unsigned* bar; unsigned x; volatile LAS unsigned* st; };
__device__ __forceinline__ XcdBarrier xcd_barrier_post(unsigned* bar, volatile LAS unsigned* st) {
    XcdBarrier b; b.bar = bar; b.x = xb_xcc_id(); b.st = st;
    if (threadIdx.x == 0) (void)xb_add(&bar[XB_XCNT(b.x)], 1u);
    return b;
}
__device__ __forceinline__ void xcd_barrier_complete(unsigned* bar, unsigned x, unsigned G, unsigned& nloc, unsigned& nx) {
    unsigned sum, cnt, mine, sp = 0u;
    for (;;) {
        sum = 0u; cnt = 0u; mine = 0u;
#pragma unroll 1
        for (unsigned j = 0; j < 16; ++j) { const unsigned c = xb_ld(&bar[XB_XCNT(j)]); sum += c; cnt += (c > 0u) ? 1u : 0u; mine = (j == x) ? c : mine; }
        if (sum == G) break;
        __builtin_amdgcn_s_sleep(1);
        if ((++sp & 255u) == 0u) { if (xb_ld(&bar[XB_TMO])) break; if (sp > XB_SPIN_CAP) { atomicAdd(&bar[XB_TMO], 1u); break; } }
    }
    nloc = mine > 0u ? mine : 1u; nx = cnt > 0u ? cnt : 1u;
}
__device__ __noinline__ void xcd_barrier(unsigned* bar_, unsigned bx_, volatile LAS unsigned* st_, int leader, unsigned G) {
    XcdBarrier b; b.bar = bar_; b.x = bx_; b.st = st_;
    asm volatile("s_waitcnt vmcnt(0) lgkmcnt(0)" ::: "memory");
    __builtin_amdgcn_s_barrier(); asm volatile("" ::: "memory");
    if (leader) {
        unsigned* bar = b.bar;
        __builtin_amdgcn_s_waitcnt(0);
        unsigned nloc = b.st[0], nx = b.st[1];
        if (nloc == 0u) { xcd_barrier_complete(bar, b.x, G, nloc, nx); b.st[0] = nloc; b.st[1] = nx; }
        const unsigned old = xb_add(&bar[XB_XSUB(b.x)], 1u);
        const unsigned gen = old / nloc;
        if (old + 1u == (gen + 1u) * nloc) {
            __builtin_amdgcn_fence(__ATOMIC_RELEASE, "agent");
            asm volatile("s_waitcnt vmcnt(0)" ::: "memory");
            const unsigned og = xb_add(&bar[XB_TOP], 1u);
            const unsigned tg = og / nx;
            if (og + 1u == (tg + 1u) * nx) xb_add(&bar[XB_TOPGEN], 1u);
            else XB_SPIN(xb_ld(&bar[XB_TOPGEN]) == tg, bar);
            __builtin_amdgcn_fence(__ATOMIC_ACQUIRE, "agent");
            xb_add(&bar[XB_XGEN(b.x)], 1u);
            asm volatile("s_waitcnt vmcnt(0)" ::: "memory");
        } else {
            XB_SPIN(xb_ld(&bar[XB_XGEN(b.x)]) == gen, bar);
            __builtin_amdgcn_fence(__ATOMIC_ACQUIRE, "agent");
            asm volatile("s_waitcnt vmcnt(0)" ::: "memory");
        }
    }
    asm volatile("s_waitcnt lgkmcnt(0)" ::: "memory");
    __builtin_amdgcn_s_barrier(); asm volatile("" ::: "memory");
}

namespace pg8 {
constexpr int BM = 256, BK = 64, HALF = 128, HTB = HALF * BK * 2, STAGE_BYTES = 8 * HTB, NXCD = 8, WGM = 8;
__host__ __device__ __forceinline__ int lds_byte(int r, int c) { const int st = (r >> 4) * 2 + (c >> 5), rr = r & 15, cc = c & 31, ob = rr * 64 + cc * 2; return st * 1024 + (ob ^ (((ob >> 9) & 1) << 5)); }
__host__ __device__ __forceinline__ void stage_rc(int b, int& R, int& C) { const int st = b / 1024, sb = b % 1024, swz = sb ^ (((sb >> 9) & 1) << 5); R = (st >> 1) * 16 + swz / 64; C = (st & 1) * 32 + (swz % 64) / 2; }
__host__ __device__ __forceinline__ int perm32(int rho) { const int n = rho >> 4, i = rho & 15; return 8 * (i >> 2) + 4 * n + (i & 3); }
__host__ __device__ __forceinline__ size_t aimg_off(int rp, int c) { return (size_t)(c >> 6) * (BM * 64) + (size_t)(rp >> 7) * (HALF * 64) + (size_t)(lds_byte(rp & 127, c & 63) >> 1); }
__host__ __device__ __forceinline__ size_t wimg_off(int n, int k, int K) {
    const int pn = n >> 8, h = (n >> 7) & 1, x = n & 127, xl = x & 31;
    const int rho = 16 * ((xl >> 2) & 1) + 4 * (xl >> 3) + (xl & 3);
    const int R = (x & ~31) + rho;
    return ((size_t)(pn * (K >> 6) + (k >> 6)) * 2 + h) * 16384 + (size_t)lds_byte(R, k & 63);
}
struct Unit { int pm, pn; };
struct Gemm { const bf16* A; const bf16* Bt; int M, N, K; int a_blocked; };
struct StaticOrder {
    int nM, nN, nwg, G, c, wgm;
    __device__ void init(int M, int N, int G_, int c_) { nM = M / BM; nN = N / BM; nwg = nM * nN; G = G_; c = c_; wgm = WGM; }
    __device__ bool next(int i, Unit& u) const {
        const long L = (long)i * G + c; if (L >= nwg) return false;
        int wgid = (int)L; { const int q = nwg / NXCD, r = nwg % NXCD, xcd = wgid % NXCD, off = wgid / NXCD; wgid = (xcd < r ? xcd * (q + 1) : r * (q + 1) + (xcd - r) * q) + off; }
        const int nig = wgm * nN, gid = wgid / nig, fm = gid * wgm, gsz = (nM - fm) < wgm ? (nM - fm) : wgm;
        u.pm = fm + ((wgid % nig) % gsz); u.pn = (wgid % nig) / gsz; return true;
    }
};
constexpr int PREF_OFF = 131072 + 4096;
template <class Epi>
__device__ __forceinline__ void gemm_phase(LAS unsigned char* lds, const Gemm g, const StaticOrder& S, const Epi& E, int wv) {
    const int tid = tid_fresh(wv), wid = __builtin_amdgcn_readfirstlane(tid >> 6), lane = tid & 63, wr = wid >> 2, wc = wid & 3, fr = lane & 15, fq = lane >> 4;
    static_assert(Epi::PERM, "the weight image in d_ws has the PERM row order baked in");
    const int K = g.K, nt = K / BK;
    unsigned voffA[2], voffB[2];
#pragma unroll
    for (int i = 0; i < 2; ++i) { int R, C; stage_rc(tid * 16 + i * 8192, R, C); const int Rb = Epi::PERM ? ((R & ~31) + perm32(R & 31)) : R;
        voffA[i] = (unsigned)(tid * 16 + i * 8192); voffB[i] = (unsigned)(tid * 16 + i * 8192); (void)Rb; (void)C; }
    const size_t tstep = (size_t)BM * K * 2;
    const size_t kstepA = (size_t)(BM * BK * 2), hstepA = (size_t)(HALF * BK * 2);
    const size_t kstep = (size_t)(BM * BK * 2), hstep = (size_t)(HALF * BK * 2);
    const unsigned ldsw = (unsigned)wid * 1024u;
    const int aoff = lds_byte(wr * 64 + fr, fq * 8), boff = lds_byte(wc * 32 + fr, fq * 8);
#define PG8_SA(b, h) (((b) * 2 + (h)) * HTB)
#define PG8_SB(b, h) ((4 + (b) * 2 + (h)) * HTB)
#define PG8_STAGE(bufoff, gbase, voff) do { _Pragma("unroll") for (int _i = 0; _i < 2; ++_i) \
        __builtin_amdgcn_global_load_lds((const unsigned*)((const char*)(gbase) + (voff)[_i]), (LAS unsigned*)(lds + (bufoff) + ldsw + _i * 8192), 16, 0, 0); } while (0)
#define PG8_LDA(dst, b, h) do { _Pragma("unroll") for (int m = 0; m < 4; ++m) _Pragma("unroll") for (int k = 0; k < 2; ++k) dst[m][k] = *(const LAS bf16x8*)(lds + PG8_SA(b, h) + aoff + m * 2048 + k * 1024); } while (0)
#define PG8_LDB(dst, b, h) do { _Pragma("unroll") for (int n = 0; n < 2; ++n) _Pragma("unroll") for (int k = 0; k < 2; ++k) dst[n][k] = *(const LAS bf16x8*)(lds + PG8_SB(b, h) + boff + n * 2048 + k * 1024); } while (0)
#define PG8_MMA(ai, bj, At, Bt) do { _Pragma("unroll") for (int m = 0; m < 4; ++m) _Pragma("unroll") for (int n = 0; n < 2; ++n) _Pragma("unroll") for (int k = 0; k < 2; ++k) \
        acc[ai][bj][m][n] = __builtin_amdgcn_mfma_f32_16x16x32_bf16(Bt[n][k], At[m][k], acc[ai][bj][m][n], 0, 0, 0); } while (0)
#define PG8_WAIT_V(n) asm volatile("s_waitcnt vmcnt(" #n ")" ::: "memory")
#define PG8_WAIT_L(n) asm volatile("s_waitcnt lgkmcnt(" #n ")" ::: "memory")
#define PG8_WAIT_VN(n) asm volatile("s_waitcnt vmcnt(%0)" :: "n"(n) : "memory")
#define PG8_BAR __builtin_amdgcn_s_barrier()
#define PG8_SCHED __builtin_amdgcn_sched_barrier(0)
    Unit cur, nxt; int ui = 0;
    if (!S.next(0, cur)) return;
    f32x4 acc[2][2][4][2];
#pragma unroll
    for (int a = 0; a < 2; ++a)
#pragma unroll
        for (int b = 0; b < 2; ++b)
#pragma unroll
            for (int m = 0; m < 4; ++m)
#pragma unroll
                for (int n = 0; n < 2; ++n) acc[a][b][m][n] = (f32x4){0.f, 0.f, 0.f, 0.f};
    bf16x8 At[4][2], B0[2][2], B1[2][2];
    const char* cA = (const char*)g.A + (size_t)cur.pm * tstep; const char* cB = (const char*)g.Bt + (size_t)cur.pn * tstep;
    PG8_STAGE(PG8_SB(0, 0), cB, voffB); PG8_STAGE(PG8_SB(0, 1), cB + hstep, voffB); PG8_STAGE(PG8_SA(0, 0), cA, voffA); PG8_STAGE(PG8_SA(0, 1), cA + hstepA, voffA);
    if (wr == 1) PG8_BAR;
    PG8_WAIT_V(2); PG8_BAR;
    PG8_STAGE(PG8_SB(1, 0), cB + kstep, voffB); PG8_STAGE(PG8_SA(1, 0), cA + kstepA, voffA); PG8_STAGE(PG8_SB(1, 1), cB + hstep + kstep, voffB);
    if constexpr (Epi::MIN_VM > 0) PG8_WAIT_V(0); else PG8_WAIT_V(6);
    PG8_BAR;
    for (;;) {
        const bool has_next = S.next(ui + 1, nxt);
        const char* nA = has_next ? (const char*)g.A + (size_t)nxt.pm * tstep : cA; const char* nB = has_next ? (const char*)g.Bt + (size_t)nxt.pn * tstep : cB;
#define PG8_ITER(FIRST) do { \
            const bool last = (t == nt - 2); \
            const char* a1 = cA + (size_t)(t + 1) * kstepA; \
            const char* a2 = last ? nA : cA + (size_t)(t + 2) * kstepA; const char* b2 = last ? nB : cB + (size_t)(t + 2) * kstep; \
            const char* a3 = a2 + kstepA; const char* b3 = b2 + kstep; \
            if constexpr (FIRST && Epi::PREF) E.pref_dma(cur, tid_fresh(wv), lds + PREF_OFF + (ui & 1) * 4096 + wid * 256); \
            PG8_LDB(B0, 0, 0); PG8_LDB(B1, 0, 1); PG8_SCHED; PG8_LDA(At, 0, 0); PG8_STAGE(PG8_SA(1, 1), a1 + hstepA, voffA); \
            if constexpr (FIRST && Epi::MIN_VM > 0) PG8_WAIT_VN(8 + Epi::MIN_VM); else PG8_WAIT_V(8); \
            PG8_WAIT_L(0); __builtin_amdgcn_s_setprio(1); PG8_BAR; PG8_MMA(0, 0, At, B0); PG8_MMA(0, 1, At, B1); __builtin_amdgcn_s_setprio(0); PG8_BAR; PG8_SCHED; \
            PG8_LDA(At, 0, 1); PG8_STAGE(PG8_SB(0, 0), b2, voffB); PG8_STAGE(PG8_SB(0, 1), b2 + hstep, voffB); PG8_STAGE(PG8_SA(0, 0), a2, voffA); \
            if constexpr (FIRST && Epi::MIN_VM > 0) PG8_WAIT_VN(8 + Epi::MIN_VM); else PG8_WAIT_V(8); \
            PG8_WAIT_L(0); __builtin_amdgcn_s_setprio(1); PG8_BAR; PG8_MMA(1, 0, At, B0); PG8_MMA(1, 1, At, B1); __builtin_amdgcn_s_setprio(0); PG8_BAR; PG8_SCHED; \
            PG8_LDB(B0, 1, 0); PG8_LDB(B1, 1, 1); PG8_SCHED; PG8_LDA(At, 1, 0); PG8_STAGE(PG8_SA(0, 1), a2 + hstepA, voffA); \
            PG8_WAIT_V(8); PG8_WAIT_L(0); __builtin_amdgcn_s_setprio(1); PG8_BAR; PG8_MMA(0, 0, At, B0); PG8_MMA(0, 1, At, B1); __builtin_amdgcn_s_setprio(0); \
            PG8_BAR; PG8_SCHED; \
            PG8_LDA(At, 1, 1); PG8_STAGE(PG8_SB(1, 0), b3, voffB); PG8_STAGE(PG8_SB(1, 1), b3 + hstep, voffB); PG8_STAGE(PG8_SA(1, 0), a3, voffA); \
            PG8_WAIT_V(8); PG8_WAIT_L(0); __builtin_amdgcn_s_setprio(1); PG8_BAR; PG8_MMA(1, 0, At, B0); PG8_MMA(1, 1, At, B1); __builtin_amdgcn_s_setprio(0); PG8_BAR; PG8_SCHED; \
        } while (0)
        { int t = 0; PG8_ITER(true); for (t = 2; t < nt; t += 2) PG8_ITER(false); }
#undef PG8_ITER
        if (wr == 0) PG8_BAR;
        { const int lane_e = tid_fresh(wv) & 63;
          E(acc, cur, wr, wc, lane_e & 15, lane_e >> 4, (LAS const float*)(lds + PREF_OFF + (ui & 1) * 4096)); }
        if constexpr (Epi::PROBE2) { if (PROBE_DUP == 7) E(acc, cur, wr, wc, fr, fq, (LAS const float*)(lds + PREF_OFF + (ui & 1) * 4096)); }
        if (!has_next) break;
#pragma unroll
        for (int a = 0; a < 2; ++a)
#pragma unroll
            for (int b = 0; b < 2; ++b)
#pragma unroll
                for (int m = 0; m < 4; ++m)
#pragma unroll
                    for (int n = 0; n < 2; ++n) acc[a][b][m][n] = (f32x4){0.f, 0.f, 0.f, 0.f};
        cur = nxt; cA = nA; cB = nB; ++ui;
        if (wr == 1) PG8_BAR;
    }
    PG8_WAIT_V(0);
    PG8_BAR; __builtin_amdgcn_s_setprio(0);
#undef PG8_SA
#undef PG8_SB
#undef PG8_STAGE
#undef PG8_LDA
#undef PG8_LDB
#undef PG8_MMA
#undef PG8_WAIT_V
#undef PG8_WAIT_L
#undef PG8_WAIT_VN
#undef PG8_BAR
#undef PG8_SCHED
}
}
using pg8::Unit; using pg8::BM; using pg8::HALF;

typedef unsigned long long u64;
struct Pre { const u64* ssq; const float* shw; int N; int row_off; float inv_n; };
__device__ __forceinline__ void pre_rstd(const Pre& P, int row0  , float (&rs)[2][4]) {
#pragma unroll
    for (int ai = 0; ai < 2; ++ai)
#pragma unroll
        for (int m = 0; m < 4; ++m) rs[ai][m] = P.ssq ? __builtin_amdgcn_rsqf((float)P.ssq[P.row_off + row0 + ai * HALF + m * 16] * P.inv_n + 1e-6f) : 1.0f;
}
__device__ __forceinline__ void pref_rstd(LAS const float* pf, const Pre& P, int r0, float (&rs)[2][4]) {
    LAS const unsigned* pu = (LAS const unsigned*)pf;
#pragma unroll
    for (int ai = 0; ai < 2; ++ai)
#pragma unroll
        for (int m = 0; m < 4; ++m) { const int r = r0 + ai * HALF + m * 16;
            rs[ai][m] = P.ssq ? __builtin_amdgcn_rsqf((float)(((u64)pu[512 + r] << 32) | pu[r]) * P.inv_n + 1e-6f) : 1.0f; }
}
__device__ __forceinline__ int bi_of(int grow0) { return grow0 < TC ? 16 : (grow0 - TC) / SEQ; }
struct EpiBf16 {
    static constexpr bool PERM = true, PROBE2 = true; static constexpr int MIN_VM = 16;
    bf16* O; int ldc; const float* bias; int act; Pre P; int blocked;
    static constexpr bool PREF = true;
    __device__ __forceinline__ void pref_dma(const Unit& u, int tid, LAS unsigned char* dst) const {
        const int i = tid & 255; const bool isrow = tid < 256;
        const unsigned* dummy = (const unsigned*)O;
        const unsigned* pr = P.ssq ? (const unsigned*)(P.ssq + P.row_off + u.pm * BM + i) : dummy;
        const unsigned* ps = P.shw ? (const unsigned*)(P.shw + (size_t)bi_of(P.row_off + u.pm * BM) * P.N + u.pn * BM + i) : dummy;
        const unsigned* pb = bias ? (const unsigned*)(bias + u.pn * BM + i) : dummy;
        __builtin_amdgcn_global_load_lds(isrow ? pr : ps, (LAS unsigned*)dst, 4, 0, 0);
        __builtin_amdgcn_global_load_lds(isrow ? pr + 1 : pb, (LAS unsigned*)(dst + 2048), 4, 0, 0);
    }
    __device__ __forceinline__ void operator()(const f32x4 (&acc)[2][2][4][2], const Unit& u, int wr, int wc, int fr, int fq, LAS const float* pf) const {
        const int row0 = u.pm * BM + wr * 64 + fr; const int col0 = u.pn * BM + wc * 32 + 8 * fq;
        float rs[2][4]; f32x4 bv[2][2];
        pref_rstd(pf, P, wr * 64 + fr, rs);
#pragma unroll
        for (int bj = 0; bj < 2; ++bj)
#pragma unroll
            for (int n = 0; n < 2; ++n) { const int ci = 256 + wc * 32 + 8 * fq + bj * HALF + 4 * n;
                bv[bj][n] = bias ? *(LAS const f32x4*)(pf + 512 + ci) : (f32x4){0.f, 0.f, 0.f, 0.f};
                if (P.shw) bv[bj][n] += *(LAS const f32x4*)(pf + ci); }
#pragma unroll
        for (int ai = 0; ai < 2; ++ai)
#pragma unroll
            for (int m = 0; m < 4; ++m) { bf16* rowp = blocked ? O + (size_t)u.pm * BM * ldc + pg8::aimg_off(wr * 64 + fr + ai * HALF + m * 16, col0)
                                                               : O + (size_t)(row0 + ai * HALF + m * 16) * ldc + col0;
                const int bjs = blocked ? 2 * BM * 64 : HALF;
#pragma unroll
                for (int bj = 0; bj < 2; ++bj) { f32x4 v0 = acc[ai][bj][m][0] * rs[ai][m] + bv[bj][0], v1 = acc[ai][bj][m][1] * rs[ai][m] + bv[bj][1];
                    if (act) {
#pragma unroll
                        for (int j = 0; j < 4; ++j) { const float a = fmaxf(v0[j], 0.f), b = fmaxf(v1[j], 0.f); v0[j] = a * a; v1[j] = b * b; } }
                    u32x4 w; w.x = cvt_pk_bf16(v0[0], v0[1]); w.y = cvt_pk_bf16(v0[2], v0[3]); w.z = cvt_pk_bf16(v1[0], v1[1]); w.w = cvt_pk_bf16(v1[2], v1[3]);
                    *(u32x4*)(rowp + bj * bjs) = w; } }
    }
};
struct EpiRope {
    static constexpr bool PERM = true, PROBE2 = false; static constexpr int MIN_VM = 16;
    bf16* O; int ldc; const f32x2* tab; int mode; Pre P;
    static constexpr bool PREF = true;
    __device__ __forceinline__ void pref_dma(const Unit& u, int tid, LAS unsigned char* dst) const {
        const int i = tid & 255; const bool isrow = tid < 256;
        const unsigned* dummy = (const unsigned*)O;
        const unsigned* pr = P.ssq ? (const unsigned*)(P.ssq + P.row_off + u.pm * BM + i) : dummy;
        const unsigned* ps = P.shw ? (const unsigned*)(P.shw + (size_t)bi_of(P.row_off + u.pm * BM) * P.N + u.pn * BM + i) : dummy;
        __builtin_amdgcn_global_load_lds(isrow ? pr : ps, (LAS unsigned*)dst, 4, 0, 0);
        __builtin_amdgcn_global_load_lds(isrow ? pr + 1 : dummy, (LAS unsigned*)(dst + 2048), 4, 0, 0);
    }
    __device__ __forceinline__ void operator()(const f32x4 (&acc)[2][2][4][2], const Unit& u, int wr, int wc, int fr, int fq, LAS const float* pf) const {
        const int row0 = u.pm * BM + wr * 64 + fr; const int col0 = u.pn * BM + wc * 32 + 8 * fq;
        const int row_off = P.row_off;
        const bool latent = (row_off + u.pm * BM) >= TC;
        float rs[2][4]; pref_rstd(pf, P, wr * 64 + fr, rs);
#pragma unroll
        for (int bj = 0; bj < 2; ++bj) {
            const int c0 = col0 + bj * HALF;
            int axis, f0, nf; bool rot;
            if (mode == 1) { const int w = c0 % 192; rot = latent && w >= 128; const int j0 = w - 128; axis = (j0 >> 5) & 1; f0 = (j0 & 31) >> 1; nf = 16; }
            else { rot = latent && c0 < 4096; const int j0 = c0 & 127; axis = j0 >> 6; f0 = (j0 & 63) >> 1; nf = 32; }
            f32x4 s0 = (f32x4){0.f, 0.f, 0.f, 0.f}, s1 = s0;
            if (P.shw) { s0 = *(LAS const f32x4*)(pf + 256 + wc * 32 + 8 * fq + bj * HALF); s1 = *(LAS const f32x4*)(pf + 256 + wc * 32 + 8 * fq + bj * HALF + 4); }
#pragma unroll
            for (int ai = 0; ai < 2; ++ai)
#pragma unroll
                for (int m = 0; m < 4; ++m) {
                    const int r = row0 + ai * HALF + m * 16;
                    f32x4 v0 = acc[ai][bj][m][0] * rs[ai][m] + s0, v1 = acc[ai][bj][m][1] * rs[ai][m] + s1;
                    if (rot) {
                        const int l = (row_off + r - TC) & (SEQ - 1); const int p = axis ? (l & 63) : (l >> 6);
                        const f32x4* tp = (const f32x4*)(tab + p * nf + f0);
                        const f32x4 t0 = tp[0], t1 = tp[1];
                        f32x4 o0, o1;
                        o0[0] = v0[0] * t0[0] - v0[1] * t0[1]; o0[1] = v0[1] * t0[0] + v0[0] * t0[1];
                        o0[2] = v0[2] * t0[2] - v0[3] * t0[3]; o0[3] = v0[3] * t0[2] + v0[2] * t0[3];
                        o1[0] = v1[0] * t1[0] - v1[1] * t1[1]; o1[1] = v1[1] * t1[0] + v1[0] * t1[1];
                        o1[2] = v1[2] * t1[2] - v1[3] * t1[3]; o1[3] = v1[3] * t1[2] + v1[2] * t1[3];
                        v0 = o0; v1 = o1;
                    }
                    u32x4 w; w.x = cvt_pk_bf16(v0[0], v0[1]); w.y = cvt_pk_bf16(v0[2], v0[3]); w.z = cvt_pk_bf16(v1[0], v1[1]); w.w = cvt_pk_bf16(v1[2], v1[3]);
                    *(u32x4*)(O + (size_t)r * ldc + c0) = w;
                }
        }
    }
};
struct EpiDqkv {
    static constexpr bool PERM = true, PROBE2 = false, PREF = false; static constexpr int MIN_VM = 0;
    bf16* CQ; bf16* CKV; bf16* KR; const float* qg; const float* kvg; const f32x2* tab; Pre P; u64* ssq_q; u64* ssq_kv; LAS float* Pl;
    __device__ __forceinline__ void operator()(const f32x4 (&acc)[2][2][4][2], const Unit& u, int wr, int wc, int fr, int fq, LAS const float* pf) const {
        const int row0 = u.pm * BM + wr * 64 + fr; const int tc0 = wc * 32 + 8 * fq;
        const int col0 = u.pn * BM + tc0;
        float rs[2][4]; pre_rstd(P, row0, rs);
        const float* shp = P.shw + (size_t)bi_of(P.row_off + u.pm * BM) * P.N + col0;
        if (u.pn < 5) {
            const bool isq = u.pn < 3;
            bf16* dst = isq ? CQ : CKV; const int ldd = isq ? 768 : 512; const int dc0 = (isq ? u.pn : u.pn - 3) * BM + tc0;
            const float* gn = (isq ? qg : kvg) + dc0;
            float ss[2][4];
#pragma unroll
            for (int ai = 0; ai < 2; ++ai)
#pragma unroll
                for (int m = 0; m < 4; ++m) ss[ai][m] = 0.f;
#pragma unroll
            for (int bj = 0; bj < 2; ++bj) {
                const f32x4 s0 = *(const f32x4*)(shp + bj * HALF), s1 = *(const f32x4*)(shp + bj * HALF + 4);
                const f32x4 g0 = *(const f32x4*)(gn + bj * HALF), g1 = *(const f32x4*)(gn + bj * HALF + 4);
#pragma unroll
                for (int ai = 0; ai < 2; ++ai)
#pragma unroll
                    for (int m = 0; m < 4; ++m) {
                        const f32x4 v0 = acc[ai][bj][m][0] * rs[ai][m] + s0, v1 = acc[ai][bj][m][1] * rs[ai][m] + s1;
                        ss[ai][m] += ((v0[0] * v0[0] + v0[1] * v0[1]) + (v0[2] * v0[2] + v0[3] * v0[3])) + ((v1[0] * v1[0] + v1[1] * v1[1]) + (v1[2] * v1[2] + v1[3] * v1[3]));
                        const f32x4 y0 = v0 * g0, y1 = v1 * g1;
                        u32x4 w; w.x = cvt_pk_bf16(y0[0], y0[1]); w.y = cvt_pk_bf16(y0[2], y0[3]); w.z = cvt_pk_bf16(y1[0], y1[1]); w.w = cvt_pk_bf16(y1[2], y1[3]);
                        *(u32x4*)(dst + (size_t)u.pm * BM * ldd + pg8::aimg_off(wr * 64 + fr + ai * HALF + m * 16, dc0 + bj * HALF)) = w;
                    }
            }
#pragma unroll
            for (int ai = 0; ai < 2; ++ai)
#pragma unroll
                for (int m = 0; m < 4; ++m) { float v = rows_sum(ss[ai][m]);
                    if (fq == 0) Pl[wc * 256 + ai * HALF + wr * 64 + m * 16 + fr] = v; }
            asm volatile("s_waitcnt lgkmcnt(0)" ::: "memory"); __builtin_amdgcn_s_barrier(); asm volatile("" ::: "memory");
            const int t = (wr * 4 + wc) * 64 + fq * 16 + fr;
            if (t < 256) { const float v = (Pl[t] + Pl[256 + t]) + (Pl[512 + t] + Pl[768 + t]);
                __hip_atomic_fetch_add((isq ? ssq_q : ssq_kv) + u.pm * BM + t, (u64)__float2ll_rn(v * 1048576.0f), __ATOMIC_RELAXED, __HIP_MEMORY_SCOPE_AGENT); }
        } else if (tc0 < 64) {
            const bool latent = (P.row_off + u.pm * BM) >= TC;
            const int axis = tc0 >> 5, f0 = (tc0 & 31) >> 1;
            const f32x4 s0 = *(const f32x4*)(shp), s1 = *(const f32x4*)(shp + 4);
#pragma unroll
            for (int ai = 0; ai < 2; ++ai)
#pragma unroll
                for (int m = 0; m < 4; ++m) {
                    const int r = row0 + ai * HALF + m * 16;
                    f32x4 v0 = acc[ai][0][m][0] * rs[ai][m] + s0, v1 = acc[ai][0][m][1] * rs[ai][m] + s1;
                    if (latent) {
                        const int l = (P.row_off + r - TC) & (SEQ - 1); const int p = axis ? (l & 63) : (l >> 6);
                        const f32x4* tp = (const f32x4*)(tab + p * 16 + f0);
                        const f32x4 t0 = tp[0], t1 = tp[1];
                        f32x4 o0, o1;
                        o0[0] = v0[0] * t0[0] - v0[1] * t0[1]; o0[1] = v0[1] * t0[0] + v0[0] * t0[1];
                        o0[2] = v0[2] * t0[2] - v0[3] * t0[3]; o0[3] = v0[3] * t0[2] + v0[2] * t0[3];
                        o1[0] = v1[0] * t1[0] - v1[1] * t1[1]; o1[1] = v1[1] * t1[0] + v1[0] * t1[1];
                        o1[2] = v1[2] * t1[2] - v1[3] * t1[3]; o1[3] = v1[3] * t1[2] + v1[2] * t1[3];
                        v0 = o0; v1 = o1;
                    }
                    u32x4 w; w.x = cvt_pk_bf16(v0[0], v0[1]); w.y = cvt_pk_bf16(v0[2], v0[3]); w.z = cvt_pk_bf16(v1[0], v1[1]); w.w = cvt_pk_bf16(v1[2], v1[3]);
                    *(u32x4*)(KR + (size_t)r * 64 + tc0) = w;
                }
        }
    }
};
struct EpiResid {
    static constexpr bool PERM = true, PROBE2 = false, PREF = false; static constexpr int MIN_VM = 0;
    bf16* H; const float* bias; const float* modl; int row_off; bf16* XG; const float* gc; u64* ssq; LAS float* Pl;
    const float* xin; const float* cin; float* fout;
    __device__ __forceinline__ void operator()(const f32x4 (&acc)[2][2][4][2], const Unit& u, int wr, int wc, int fr, int fq, LAS const float* pf) const {
        const int grow0 = row_off + u.pm * BM; const int bi = bi_of(grow0);
        const int row0 = grow0 + wr * 64 + fr, col0 = u.pn * BM + wc * 32 + 8 * fq;
        const float* gp = modl + (size_t)bi * NMOD + col0;
        const float* gcp = gc + (size_t)bi * DM + col0;
        const float* h32 = xin ? (grow0 < TC ? cin + (size_t)row0 * DM : xin + (size_t)(row0 - TC) * DM) : nullptr;
        float ss[2][4];
#pragma unroll
        for (int ai = 0; ai < 2; ++ai)
#pragma unroll
            for (int m = 0; m < 4; ++m) ss[ai][m] = 0.f;
#pragma unroll
        for (int bj = 0; bj < 2; ++bj) {
            const int co = bj * HALF;
            u32x4 hwa[2][4];
            if (!h32) {
#pragma unroll
                for (int ai = 0; ai < 2; ++ai)
#pragma unroll
                    for (int m = 0; m < 4; ++m) hwa[ai][m] = *(const u32x4*)(H + (size_t)row0 * DM + (size_t)(ai * HALF + m * 16) * DM + col0 + co);
            }
            const f32x4 gv0 = *(const f32x4*)(gp + co), gv1 = *(const f32x4*)(gp + co + 4);
            const f32x4 bv0 = bias ? *(const f32x4*)(bias + col0 + co) : (f32x4){0.f, 0.f, 0.f, 0.f}, bv1 = bias ? *(const f32x4*)(bias + col0 + co + 4) : (f32x4){0.f, 0.f, 0.f, 0.f};
            const f32x4 gc0 = gc ? *(const f32x4*)(gcp + co) : (f32x4){0.f, 0.f, 0.f, 0.f}, gc1 = gc ? *(const f32x4*)(gcp + co + 4) : (f32x4){0.f, 0.f, 0.f, 0.f};
            const int col = col0 + co;
#pragma unroll
            for (int ai = 0; ai < 2; ++ai) {
#pragma unroll
                for (int m = 0; m < 4; ++m) {
                    const size_t ro = (size_t)(ai * HALF + m * 16) * DM + col;
                    const size_t o = (size_t)row0 * DM + ro;
                    f32x4 h0, h1;
                    if (h32) { h0 = *(const f32x4*)(h32 + ro); h1 = *(const f32x4*)(h32 + ro + 4); }
                    else { const u32x4 hw = hwa[ai][m];
                        h0 = (f32x4){__uint_as_float(hw.x << 16), __uint_as_float(hw.x & 0xffff0000u), __uint_as_float(hw.y << 16), __uint_as_float(hw.y & 0xffff0000u)};
                        h1 = (f32x4){__uint_as_float(hw.z << 16), __uint_as_float(hw.z & 0xffff0000u), __uint_as_float(hw.w << 16), __uint_as_float(hw.w & 0xffff0000u)}; }
                    const f32x4 n0 = h0 + gv0 * (acc[ai][bj][m][0] + bv0), n1 = h1 + gv1 * (acc[ai][bj][m][1] + bv1);
                    if (fout) { float* fo = fout + (o - (size_t)TC * DM); *(f32x4*)fo = n0; *(f32x4*)(fo + 4) = n1; }
                    else { u32x4 w; w.x = cvt_pk_bf16(n0[0], n0[1]); w.y = cvt_pk_bf16(n0[2], n0[3]); w.z = cvt_pk_bf16(n1[0], n1[1]); w.w = cvt_pk_bf16(n1[2], n1[3]); *(u32x4*)(H + o) = w; }
                    if (gc) { const f32x4 x0 = n0 * gc0, x1 = n1 * gc1; u32x4 w; w.x = cvt_pk_bf16(x0[0], x0[1]); w.y = cvt_pk_bf16(x0[2], x0[3]); w.z = cvt_pk_bf16(x1[0], x1[1]); w.w = cvt_pk_bf16(x1[2], x1[3]);
                        *(u32x4*)(XG + (size_t)grow0 * DM + pg8::aimg_off(wr * 64 + fr + ai * HALF + m * 16, col)) = w;
                        ss[ai][m] += ((n0[0] * n0[0] + n0[1] * n0[1]) + (n0[2] * n0[2] + n0[3] * n0[3])) + ((n1[0] * n1[0] + n1[1] * n1[1]) + (n1[2] * n1[2] + n1[3] * n1[3])); }
                }
                asm volatile("" ::: "memory");
            }
        }
        if (gc) {
#pragma unroll
            for (int ai = 0; ai < 2; ++ai)
#pragma unroll
                for (int m = 0; m < 4; ++m) { float v = rows_sum(ss[ai][m]);
                    if (fq == 0) Pl[wc * 256 + ai * HALF + wr * 64 + m * 16 + fr] = v; }
            asm volatile("s_waitcnt lgkmcnt(0)" ::: "memory"); __builtin_amdgcn_s_barrier(); asm volatile("" ::: "memory");
            const int t = (wr * 4 + wc) * 64 + fq * 16 + fr;
            if (t < 256) { const float v = (Pl[t] + Pl[256 + t]) + (Pl[512 + t] + Pl[768 + t]);
                __hip_atomic_fetch_add(ssq + grow0 + t, (u64)__float2ll_rn(v * 1048576.0f), __ATOMIC_RELAXED, __HIP_MEMORY_SCOPE_AGENT); }
        }
    }
};

__device__ __forceinline__ void gemm_bf16(int wv, const bf16* A, const bf16* Bt, int M, int N, int K, bf16* O, int ldc, const float* bias, int act, Pre P, int blocked = 0, int a_blocked = 0) {
    extern __shared__ __attribute__((aligned(16))) unsigned char lds[];
    pg8::Gemm g{A, Bt, M, N, K, a_blocked}; pg8::StaticOrder S; S.init(M, N, (int)gridDim.x, (int)blockIdx.x);
    EpiBf16 E{O, ldc, bias, act, P, blocked}; pg8::gemm_phase<EpiBf16>((LAS unsigned char*)lds, g, S, E, wv);
}
__device__ __forceinline__ void gemm_rope(int wv, const bf16* A, const bf16* Bt, int M, int N, int K, bf16* O, int ldc, const f32x2* tab, int mode, Pre P, int a_blocked = 0) {
    extern __shared__ __attribute__((aligned(16))) unsigned char lds[];
    pg8::Gemm g{A, Bt, M, N, K, a_blocked}; pg8::StaticOrder S; S.init(M, N, (int)gridDim.x, (int)blockIdx.x);
    EpiRope E{O, ldc, tab, mode, P}; pg8::gemm_phase<EpiRope>((LAS unsigned char*)lds, g, S, E, wv);
}
__device__ __forceinline__ void gemm_dqkv(int wv, const bf16* A, const bf16* Bt, bf16* CQ, bf16* CKV, bf16* KR, const float* qg, const float* kvg, const f32x2* tab, Pre P, u64* ssq_q, u64* ssq_kv) {
    extern __shared__ __attribute__((aligned(16))) unsigned char lds[];
    pg8::Gemm g{A, Bt, TT, 1536, DM, 1}; pg8::StaticOrder S; S.init(TT, 1536, (int)gridDim.x, (int)blockIdx.x);
    EpiDqkv E{CQ, CKV, KR, qg, kvg, tab, P, ssq_q, ssq_kv, (LAS float*)((LAS unsigned char*)lds + 131072)}; pg8::gemm_phase<EpiDqkv>((LAS unsigned char*)lds, g, S, E, wv);
}
__device__ __forceinline__ void gemm_resid(int wv, const bf16* A, const bf16* Bt, int M, int N, int K, bf16* H, const float* bias, const float* modl, int row_off, bf16* XG, const float* gc, u64* ssq,
                                           const float* xin, const float* cin, float* fout, int a_blocked = 0) {
    extern __shared__ __attribute__((aligned(16))) unsigned char lds[];
    pg8::Gemm g{A, Bt, M, N, K, a_blocked}; pg8::StaticOrder S; S.init(M, N, (int)gridDim.x, (int)blockIdx.x); if (K == DFF) S.wgm = 4;
    EpiResid E{H, bias, modl, row_off, XG, gc, ssq, (LAS float*)((LAS unsigned char*)lds + 131072), xin, cin, fout}; pg8::gemm_phase<EpiResid>((LAS unsigned char*)lds, g, S, E, wv);
}

#define KSWZ(row, colB) ((row) * 256 + ((colB) ^ (((row) & 7) << 4)))
#define KRSWZ(row, colB) ((row) * 128 + ((colB) ^ ((((row) >> 1) & 7) << 4)))
#define SBAR() __builtin_amdgcn_sched_barrier(0)
__device__ __forceinline__ int crow(int r, int hi) { return (r & 3) + 8 * (r >> 2) + 4 * hi; }
constexpr int KVBLK = 64;
constexpr int SHM_V = KVBLK * 128 * 2, SHM_K = KVBLK * 128 * 2, SHM_KR = KVBLK * 64 * 2;
__device__ __forceinline__ void partialSM(f32x16& p0, f32x16& p1, float& m_reg, float& mn, float& alpha, float C, float thr) {
    float pmax = p0[0];
#pragma unroll
    for (int r = 1; r < 16; ++r) pmax = fmaxf(pmax, p0[r]);
#pragma unroll
    for (int r = 0; r < 16; ++r) pmax = fmaxf(pmax, p1[r]);
    { auto rr = __builtin_amdgcn_permlane32_swap(__float_as_uint(pmax), __float_as_uint(pmax), false, false);
      pmax = fmaxf(__uint_as_float(rr[0]), __uint_as_float(rr[1])); }
    if (__builtin_expect(__all(pmax - m_reg <= thr), 1)) { mn = m_reg; alpha = 1.f; }
    else { mn = fmaxf(m_reg, pmax); alpha = __builtin_amdgcn_exp2f((m_reg - mn) * C); m_reg = mn; }
    const float mnC = -mn * C;
#pragma unroll
    for (int r = 0; r < 16; ++r) p0[r] = fmaf(p0[r], C, mnC);
#pragma unroll
    for (int r = 0; r < 16; ++r) p1[r] = fmaf(p1[r], C, mnC);
#pragma unroll
    for (int r = 0; r < 16; ++r) p0[r] = __builtin_amdgcn_exp2f(p0[r]);
}
__device__ __forceinline__ void finishSM(f32x16& p0, f32x16& p1, float alpha, float& l_reg, bf16x8& pa0, bf16x8& pa1, bf16x8& pa2, bf16x8& pa3) {
#pragma unroll
    for (int r = 0; r < 16; ++r) p1[r] = __builtin_amdgcn_exp2f(p1[r]);
    float ps = 0;
#pragma unroll
    for (int r = 0; r < 16; ++r) ps += p0[r];
#pragma unroll
    for (int r = 0; r < 16; ++r) ps += p1[r];
    { auto rr = __builtin_amdgcn_permlane32_swap(__float_as_uint(ps), __float_as_uint(ps), false, false);
      ps = __uint_as_float(rr[0]) + __uint_as_float(rr[1]); }
    l_reg = l_reg * alpha + ps;
#define PK4(P, BASE, OUT) do { unsigned a0 = cvt_pk_bf16(P[BASE + 0], P[BASE + 1]), a1 = cvt_pk_bf16(P[BASE + 2], P[BASE + 3]);   \
    unsigned b0 = cvt_pk_bf16(P[BASE + 4], P[BASE + 5]), b1 = cvt_pk_bf16(P[BASE + 6], P[BASE + 7]);                              \
    auto r0 = __builtin_amdgcn_permlane32_swap(a0, b0, false, false); auto r1 = __builtin_amdgcn_permlane32_swap(a1, b1, false, false); \
    u32x4 w = {r0[0], r1[0], r0[1], r1[1]}; OUT = *reinterpret_cast<bf16x8*>(&w); } while (0)
    PK4(p0, 0, pa0); PK4(p0, 8, pa1); PK4(p1, 0, pa2); PK4(p1, 8, pa3);
#undef PK4
}
template <int NDQ>
__device__ __forceinline__ void qkt(f32x16& p0, f32x16& p1, const char* Ks, const char* Krs, const bf16x8* qr, const char* qrl, int r32, int hi) {
    p0 = f32x16{}; p1 = f32x16{};
#pragma unroll
    for (int d0 = 0; d0 < 8; ++d0) { const int cb = (d0 * 16 + hi * 8) * 2;
        const bf16x8 b0 = *reinterpret_cast<const bf16x8*>(Ks + KSWZ(r32, cb));
        const bf16x8 b1 = *reinterpret_cast<const bf16x8*>(Ks + KSWZ(32 + r32, cb));
        p0 = __builtin_amdgcn_mfma_f32_32x32x16_bf16(b0, qr[d0], p0, 0, 0, 0);
        p1 = __builtin_amdgcn_mfma_f32_32x32x16_bf16(b1, qr[d0], p1, 0, 0, 0); }
    if constexpr (NDQ > 8) {
#pragma unroll
        for (int d0 = 8; d0 < NDQ; ++d0) { const int cb = ((d0 - 8) * 16 + hi * 8) * 2;
            const bf16x8 b0 = *reinterpret_cast<const bf16x8*>(Krs + KRSWZ(r32, cb));
            const bf16x8 b1 = *reinterpret_cast<const bf16x8*>(Krs + KRSWZ(32 + r32, cb));
            const bf16x8 qf = *reinterpret_cast<const bf16x8*>(qrl + (d0 - 8) * 1024);
            p0 = __builtin_amdgcn_mfma_f32_32x32x16_bf16(b0, qf, p0, 0, 0, 0);
            p1 = __builtin_amdgcn_mfma_f32_32x32x16_bf16(b1, qf, p1, 0, 0, 0); }
    }
}
__device__ __forceinline__ int v_st(int k, int c) { const int kk = (k & ~0xC) | ((k & 4) << 1) | ((k & 8) >> 1); return ((kk >> 3) * 4 + (c >> 5)) * 512 + ((kk & 7) * 32 + (c & 31)) * 2; }
__device__ __forceinline__ int v_rd_base(int lane) { return ((lane & 3) << 3) | (((lane >> 2) & 3) << 6) | (((lane >> 4) & 1) << 5) | (((lane >> 5) & 1) << 8); }
constexpr int v_rd_off(int d0, int ks, int half) { return d0 * 512 + ks * 4096 + half * 2048; }
template <int OFF> __device__ __forceinline__ s16x4 tr_read(int vb) {
    s16x4 r; asm volatile("ds_read_b64_tr_b16 %0, %1 offset:%2" : "=&v"(r) : "v"(vb), "i"(OFF) : "memory"); return r;
}
template <int D0> __device__ __forceinline__ void pv_one(f32x16& od, int vb, bf16x8 pa0, bf16x8 pa1, bf16x8 pa2, bf16x8 pa3) {
    const s16x4 l0 = tr_read<v_rd_off(D0, 0, 0)>(vb), h0 = tr_read<v_rd_off(D0, 0, 1)>(vb), l1 = tr_read<v_rd_off(D0, 1, 0)>(vb), h1 = tr_read<v_rd_off(D0, 1, 1)>(vb);
    const s16x4 l2 = tr_read<v_rd_off(D0, 2, 0)>(vb), h2 = tr_read<v_rd_off(D0, 2, 1)>(vb), l3 = tr_read<v_rd_off(D0, 3, 0)>(vb), h3 = tr_read<v_rd_off(D0, 3, 1)>(vb);
    asm volatile("s_waitcnt lgkmcnt(0)" ::: "memory"); SBAR();
#define PK(L, H) (bf16x8){L[0], L[1], L[2], L[3], H[0], H[1], H[2], H[3]}
    od = __builtin_amdgcn_mfma_f32_32x32x16_bf16(pa0, PK(l0, h0), od, 0, 0, 0);
    od = __builtin_amdgcn_mfma_f32_32x32x16_bf16(pa1, PK(l1, h1), od, 0, 0, 0);
    od = __builtin_amdgcn_mfma_f32_32x32x16_bf16(pa2, PK(l2, h2), od, 0, 0, 0);
    od = __builtin_amdgcn_mfma_f32_32x32x16_bf16(pa3, PK(l3, h3), od, 0, 0, 0);
#undef PK
}
__device__ __forceinline__ void pv_d0(f32x16* o, int vb, bf16x8 pa0, bf16x8 pa1, bf16x8 pa2, bf16x8 pa3) {
    pv_one<0>(o[0], vb, pa0, pa1, pa2, pa3); pv_one<1>(o[1], vb, pa0, pa1, pa2, pa3); pv_one<2>(o[2], vb, pa0, pa1, pa2, pa3); pv_one<3>(o[3], vb, pa0, pa1, pa2, pa3);
}
template <int D0> __device__ __forceinline__ void pv_reads(int vb, s16x4 (&t)[8]) {
    t[0] = tr_read<v_rd_off(D0, 0, 0)>(vb); t[1] = tr_read<v_rd_off(D0, 0, 1)>(vb); t[2] = tr_read<v_rd_off(D0, 1, 0)>(vb); t[3] = tr_read<v_rd_off(D0, 1, 1)>(vb);
    t[4] = tr_read<v_rd_off(D0, 2, 0)>(vb); t[5] = tr_read<v_rd_off(D0, 2, 1)>(vb); t[6] = tr_read<v_rd_off(D0, 3, 0)>(vb); t[7] = tr_read<v_rd_off(D0, 3, 1)>(vb);
}
__device__ __forceinline__ void pv_mma(f32x16& od, s16x4 (&t)[8], bf16x8 pa0, bf16x8 pa1, bf16x8 pa2, bf16x8 pa3) {
#define PK(L, H) (bf16x8){L[0], L[1], L[2], L[3], H[0], H[1], H[2], H[3]}
    asm volatile("" : "+v"(t[0]), "+v"(t[1]), "+v"(t[2]), "+v"(t[3]), "+v"(t[4]), "+v"(t[5]), "+v"(t[6]), "+v"(t[7]));
    od = __builtin_amdgcn_mfma_f32_32x32x16_bf16(pa0, PK(t[0], t[1]), od, 0, 0, 0);
    od = __builtin_amdgcn_mfma_f32_32x32x16_bf16(pa1, PK(t[2], t[3]), od, 0, 0, 0);
    od = __builtin_amdgcn_mfma_f32_32x32x16_bf16(pa2, PK(t[4], t[5]), od, 0, 0, 0);
    od = __builtin_amdgcn_mfma_f32_32x32x16_bf16(pa3, PK(t[6], t[7]), od, 0, 0, 0);
#undef PK
}
__device__ __forceinline__ void pv_pipe(f32x16* o, int vb, bf16x8 pa0, bf16x8 pa1, bf16x8 pa2, bf16x8 pa3) {
    s16x4 ta[8], tb[8];
    pv_reads<0>(vb, ta);
    pv_reads<1>(vb, tb); asm volatile("s_waitcnt lgkmcnt(8)" ::: "memory"); SBAR(); pv_mma(o[0], ta, pa0, pa1, pa2, pa3);
    pv_reads<2>(vb, ta); asm volatile("s_waitcnt lgkmcnt(8)" ::: "memory"); SBAR(); pv_mma(o[1], tb, pa0, pa1, pa2, pa3);
    pv_reads<3>(vb, tb); asm volatile("s_waitcnt lgkmcnt(8)" ::: "memory"); SBAR(); pv_mma(o[2], ta, pa0, pa1, pa2, pa3);
    asm volatile("s_waitcnt lgkmcnt(0)" ::: "memory"); SBAR(); pv_mma(o[3], tb, pa0, pa1, pa2, pa3);
}
__device__ __forceinline__ void softmax_tile(f32x16& p0, f32x16& p1, float& m_reg, float& l_reg, float& alpha, float C, float thr, bf16x8& pa0, bf16x8& pa1, bf16x8& pa2, bf16x8& pa3) {
    float mn; partialSM(p0, p1, m_reg, mn, alpha, C, thr); (void)mn;
    finishSM(p0, p1, alpha, l_reg, pa0, pa1, pa2, pa3);
}
template <int NDQ>
__device__ __forceinline__ void attn_body2(int wv, const bf16* __restrict__ Qb, int ldq, const bf16* __restrict__ Kn, int ldk, const bf16* __restrict__ Kr,
                                           const bf16* __restrict__ V, int ldv, bf16* __restrict__ Ob, int ocol,
                                           int cbase, int lbase, int nct, int NT, float C, float thr, char* lds) {
    const int tid = tid_fresh(wv), wid = tid >> 6, lane = tid & 63, r32 = lane & 31, hi = lane >> 5;
    const bool lead = wid < 4;
    char* V_lds = lds; char* K_lds = lds + 2 * SHM_V; char* Kr_lds = lds + 2 * SHM_V + 2 * SHM_K;
    float* wsf = (float*)(lds + 2 * SHM_V + 2 * SHM_K + 2 * SHM_KR) + wid * 64; float* li_l = wsf; float* al_l = wsf + 32;
    float m_reg = -1e30f, l_reg = 0; f32x16 o[4] = {}; bf16x8 qr[8];
    const bf16* Qw = Qb + (size_t)(wid * 32 + r32) * ldq + hi * 8;
#pragma unroll
    for (int d0 = 0; d0 < 8; ++d0) qr[d0] = *reinterpret_cast<const bf16x8*>(Qw + d0 * 16);
    char* qrl = lds + 2 * SHM_V + 2 * SHM_K + 2 * SHM_KR + 2048 + wid * 4096 + lane * 16;
    if constexpr (NDQ > 8) {
#pragma unroll
        for (int d0 = 8; d0 < NDQ; ++d0) *reinterpret_cast<bf16x8*>(qrl + (d0 - 8) * 1024) = *reinterpret_cast<const bf16x8*>(Qw + d0 * 16);
        asm volatile("s_waitcnt lgkmcnt(0)" ::: "memory");
    }
    const int sr = tid >> 4, sc = (tid & 15) * 8, vst0 = v_st(sr, sc), vst1 = v_st(32 + sr, sc);
    const int rr = tid >> 3, rc = (tid & 7) * 8;
    const int vb0 = (int)(uintptr_t)V_lds + v_rd_base(lane);
    bf16x8 svs0, svs1, sks0, sks1, skr;
#define KROW2(j) ((j) < nct ? cbase + (j) * KVBLK : lbase + ((j) - nct) * KVBLK)
#define SLOAD2(j) do { const int k0_ = KROW2(j); svs0 = *reinterpret_cast<const bf16x8*>(&V[(size_t)(k0_ + sr) * ldv + sc]); svs1 = *reinterpret_cast<const bf16x8*>(&V[(size_t)(k0_ + 32 + sr) * ldv + sc]); \
    sks0 = *reinterpret_cast<const bf16x8*>(&Kn[(size_t)(k0_ + sr) * ldk + sc]); sks1 = *reinterpret_cast<const bf16x8*>(&Kn[(size_t)(k0_ + 32 + sr) * ldk + sc]); \
    if constexpr (NDQ > 8) skr = *reinterpret_cast<const bf16x8*>(&Kr[(size_t)(k0_ + rr) * 64 + rc]); } while (0)
#define SWRITE2(b) do { *(bf16x8*)(V_lds + (b) * SHM_V + vst0) = svs0; *(bf16x8*)(V_lds + (b) * SHM_V + vst1) = svs1; const int kc = sc * 2; \
    *(bf16x8*)(K_lds + (b) * SHM_K + KSWZ(sr, kc)) = sks0; *(bf16x8*)(K_lds + (b) * SHM_K + KSWZ(32 + sr, kc)) = sks1; \
    if constexpr (NDQ > 8) *(bf16x8*)(Kr_lds + (b) * SHM_KR + KRSWZ(rr, rc * 2)) = skr; } while (0)
#define RESC2(a) do { if (__any((a) < 1.f)) { if (hi == 0) al_l[r32] = (a); asm volatile("s_waitcnt lgkmcnt(0)" ::: "memory"); \
    _Pragma("unroll") for (int d = 0; d < 4; ++d) _Pragma("unroll") for (int r = 0; r < 16; ++r) o[d][r] *= al_l[crow(r, hi)]; } } while (0)
    f32x16 S0, S1; float alpha = 1.f; bf16x8 pa0, pa1, pa2, pa3;
    if (!lead) __builtin_amdgcn_s_setprio(1);
    SLOAD2(0); asm volatile("s_waitcnt vmcnt(0)" ::: "memory"); SWRITE2(0); __syncthreads();
    if (1 < NT) SLOAD2(1);
    SBAR(); qkt<NDQ>(S0, S1, K_lds, Kr_lds, qr, qrl, r32, hi); SBAR();
    if (lead) { softmax_tile(S0, S1, m_reg, l_reg, alpha, C, thr, pa0, pa1, pa2, pa3); }
    __syncthreads(); asm volatile("s_waitcnt vmcnt(0)" ::: "memory"); if (1 < NT) SWRITE2(1); __syncthreads();
    for (int j = 1; j < NT; ++j) {
        const int b = j & 1;
        if (j + 1 < NT) SLOAD2(j + 1);
        const char* Kb = K_lds + b * SHM_K; const char* Krb = Kr_lds + b * SHM_KR; const int vbp = vb0 + (b ^ 1) * SHM_V;
        if (lead) {
            SBAR(); pv_pipe(o, vbp, pa0, pa1, pa2, pa3); qkt<NDQ>(S0, S1, Kb, Krb, qr, qrl, r32, hi); SBAR();
            softmax_tile(S0, S1, m_reg, l_reg, alpha, C, thr, pa0, pa1, pa2, pa3); RESC2(alpha); SBAR();
        } else {
            SBAR(); softmax_tile(S0, S1, m_reg, l_reg, alpha, C, thr, pa0, pa1, pa2, pa3); RESC2(alpha); SBAR();
            qkt<NDQ>(S0, S1, Kb, Krb, qr, qrl, r32, hi); pv_pipe(o, vbp, pa0, pa1, pa2, pa3); SBAR();
        }
        __syncthreads(); asm volatile("s_waitcnt vmcnt(0)" ::: "memory"); if (j + 1 < NT) SWRITE2(b ^ 1); __syncthreads();
    }
    if (!lead) { softmax_tile(S0, S1, m_reg, l_reg, alpha, C, thr, pa0, pa1, pa2, pa3); RESC2(alpha); }
    SBAR(); pv_pipe(o, vb0 + ((NT - 1) & 1) * SHM_V, pa0, pa1, pa2, pa3);
    __builtin_amdgcn_s_setprio(0);
    if (hi == 0) li_l[r32] = l_reg; asm volatile("s_waitcnt lgkmcnt(0)" ::: "memory");
    float rli[16];
#pragma unroll
    for (int r = 0; r < 16; ++r) rli[r] = __builtin_amdgcn_rcpf(li_l[crow(r, hi)]);
    __syncthreads();
    { char* ost = lds + wid * 8704;
#pragma unroll
      for (int r = 0; r < 16; ++r) { const int orow = crow(r, hi);
#pragma unroll
          for (int d0 = 0; d0 < 4; ++d0) *(bf16*)(ost + orow * 272 + (d0 * 32 + r32) * 2) = f2bf(o[d0][r] * rli[r]); }
      asm volatile("s_waitcnt lgkmcnt(0)" ::: "memory");
#pragma unroll
      for (int i = 0; i < 8; ++i) { const int row = (lane >> 4) + 4 * i, chunk = lane & 15;
          const u32x4 v = *(const u32x4*)(ost + row * 272 + chunk * 16);
          *(u32x4*)(Ob + pg8::aimg_off(wid * 32 + row, ocol + chunk * 8)) = v; } }
    __syncthreads();
#undef KROW2
#undef SLOAD2
#undef SWRITE2
#undef RESC2
}
template <int NDV> __device__ __forceinline__ int v_st4(int k, int c) { const int kk = (k & ~0xC) | ((k & 4) << 1) | ((k & 8) >> 1); return ((kk >> 3) * NDV + (c >> 5)) * 512 + ((kk & 7) * 32 + (c & 31)) * 2; }
template <int NDV> constexpr int v_rd_off4(int d0, int ks, int half) { return d0 * 512 + ks * (2 * NDV * 512) + half * (NDV * 512); }
template <int D0, int NDV> __device__ __forceinline__ void pv_reads4(int vb, s16x4 (&t)[8]) {
    t[0] = tr_read<v_rd_off4<NDV>(D0, 0, 0)>(vb); t[1] = tr_read<v_rd_off4<NDV>(D0, 0, 1)>(vb); t[2] = tr_read<v_rd_off4<NDV>(D0, 1, 0)>(vb); t[3] = tr_read<v_rd_off4<NDV>(D0, 1, 1)>(vb);
    t[4] = tr_read<v_rd_off4<NDV>(D0, 2, 0)>(vb); t[5] = tr_read<v_rd_off4<NDV>(D0, 2, 1)>(vb); t[6] = tr_read<v_rd_off4<NDV>(D0, 3, 0)>(vb); t[7] = tr_read<v_rd_off4<NDV>(D0, 3, 1)>(vb);
}
template <int D0, int NDV> struct PvChain {
    static __device__ __forceinline__ void run(f32x16* o, int vb, bf16x8 pa0, bf16x8 pa1, bf16x8 pa2, bf16x8 pa3, s16x4 (&cur)[8], s16x4 (&nxt)[8]) {
        if constexpr (D0 + 1 < NDV) { pv_reads4<D0 + 1, NDV>(vb, nxt); asm volatile("s_waitcnt lgkmcnt(8)" ::: "memory"); } else { asm volatile("s_waitcnt lgkmcnt(0)" ::: "memory"); }
        SBAR(); pv_mma(o[D0], cur, pa0, pa1, pa2, pa3);
        if constexpr (D0 + 1 < NDV) PvChain<D0 + 1, NDV>::run(o, vb, pa0, pa1, pa2, pa3, nxt, cur);
    }
};
template <int D0, int NDV> struct PvSeq {
    static __device__ __forceinline__ void run(f32x16* o, int vb, bf16x8 pa0, bf16x8 pa1, bf16x8 pa2, bf16x8 pa3) {
        s16x4 t[8]; pv_reads4<D0, NDV>(vb, t); asm volatile("s_waitcnt lgkmcnt(0)" ::: "memory"); SBAR(); pv_mma(o[D0], t, pa0, pa1, pa2, pa3);
        if constexpr (D0 + 1 < NDV) PvSeq<D0 + 1, NDV>::run(o, vb, pa0, pa1, pa2, pa3);
    }
};
template <int NDV> __device__ __forceinline__ void pv_pipe4(f32x16* o, int vb, bf16x8 pa0, bf16x8 pa1, bf16x8 pa2, bf16x8 pa3) {
    if constexpr (NDV > 8) { PvSeq<0, NDV>::run(o, vb, pa0, pa1, pa2, pa3); }
    else { s16x4 ta[8], tb[8]; pv_reads4<0, NDV>(vb, ta); PvChain<0, NDV>::run(o, vb, pa0, pa1, pa2, pa3, ta, tb); }
}
template <int D0, int NQR> __device__ __forceinline__ void qk_read1(const char* Ks, const char* Krs, const char* qrl, int r32, int hi, bf16x8& b0, bf16x8& b1, bf16x8& qf) {
    if constexpr (D0 < 8) { const int cb = (D0 * 16 + hi * 8) * 2; b0 = *reinterpret_cast<const bf16x8*>(Ks + KSWZ(r32, cb)); b1 = *reinterpret_cast<const bf16x8*>(Ks + KSWZ(32 + r32, cb)); }
    else { const int cb = ((D0 - 8) * 16 + hi * 8) * 2; b0 = *reinterpret_cast<const bf16x8*>(Krs + KRSWZ(r32, cb)); b1 = *reinterpret_cast<const bf16x8*>(Krs + KRSWZ(32 + r32, cb)); }
    if constexpr (D0 >= NQR) qf = *reinterpret_cast<const bf16x8*>(qrl + (D0 - NQR) * 1024);
}
template <int G, int GS, int NQR> __device__ __forceinline__ void qk_reads(const char* Ks, const char* Krs, const char* qrl, int r32, int hi, bf16x8 (&k)[2 * GS], bf16x8 (&q)[GS]) {
    qk_read1<G * GS, NQR>(Ks, Krs, qrl, r32, hi, k[0], k[1], q[0]);
    if constexpr (GS > 1) qk_read1<G * GS + 1, NQR>(Ks, Krs, qrl, r32, hi, k[2], k[3], q[1]);
}
template <int N> __device__ __forceinline__ void lgkm_wait() {
    static_assert(N >= 0 && N <= 6, "counted LDS wait");
    if constexpr (N == 0) asm volatile("s_waitcnt lgkmcnt(0)" ::: "memory"); else if constexpr (N == 1) asm volatile("s_waitcnt lgkmcnt(1)" ::: "memory");
    else if constexpr (N == 2) asm volatile("s_waitcnt lgkmcnt(2)" ::: "memory"); else if constexpr (N == 3) asm volatile("s_waitcnt lgkmcnt(3)" ::: "memory");
    else if constexpr (N == 4) asm volatile("s_waitcnt lgkmcnt(4)" ::: "memory"); else if constexpr (N == 5) asm volatile("s_waitcnt lgkmcnt(5)" ::: "memory");
    else asm volatile("s_waitcnt lgkmcnt(6)" ::: "memory");
}
template <int G, int GS, int NDQ, int NQR> struct QkChain {
    static __device__ __forceinline__ void run(f32x16& p0, f32x16& p1, const char* Ks, const char* Krs, const bf16x8* qr, const char* qrl, int r32, int hi,
                                               bf16x8 (&ck)[2 * GS], bf16x8 (&cq)[GS], bf16x8 (&nk)[2 * GS], bf16x8 (&nq)[GS]) {
        constexpr int NG = NDQ / GS;
        if constexpr (G + 1 < NG) {
            qk_reads<G + 1, GS, NQR>(Ks, Krs, qrl, r32, hi, nk, nq);
            constexpr int D1 = (G + 1) * GS; constexpr int NR = 2 * GS + (D1 >= NQR ? 1 : 0) + ((GS > 1 && D1 + 1 >= NQR) ? 1 : 0);
            lgkm_wait<NR>();
        } else lgkm_wait<0>();
        SBAR();
#pragma unroll
        for (int s_ = 0; s_ < GS; ++s_) { const int d0 = G * GS + s_; const bf16x8 qf = d0 < NQR ? qr[d0 < NQR ? d0 : 0] : cq[s_];
            p0 = __builtin_amdgcn_mfma_f32_32x32x16_bf16(ck[2 * s_], qf, p0, 0, 0, 0);
            p1 = __builtin_amdgcn_mfma_f32_32x32x16_bf16(ck[2 * s_ + 1], qf, p1, 0, 0, 0); }
        if constexpr (G + 1 < NG) QkChain<G + 1, GS, NDQ, NQR>::run(p0, p1, Ks, Krs, qr, qrl, r32, hi, nk, nq, ck, cq);
    }
};
template <int NDQ, int NQR>
__device__ __forceinline__ void qkt4_seq(f32x16& p0, f32x16& p1, const char* Ks, const char* Krs, const bf16x8* qr, const char* qrl, int r32, int hi) {
    p0 = f32x16{}; p1 = f32x16{};
#pragma unroll
    for (int d0 = 0; d0 < NDQ; ++d0) {
        bf16x8 b0, b1;
        if (d0 < 8) { const int cb = (d0 * 16 + hi * 8) * 2; b0 = *reinterpret_cast<const bf16x8*>(Ks + KSWZ(r32, cb)); b1 = *reinterpret_cast<const bf16x8*>(Ks + KSWZ(32 + r32, cb)); }
        else { const int cb = ((d0 - 8) * 16 + hi * 8) * 2; b0 = *reinterpret_cast<const bf16x8*>(Krs + KRSWZ(r32, cb)); b1 = *reinterpret_cast<const bf16x8*>(Krs + KRSWZ(32 + r32, cb)); }
        bf16x8 qf; if (d0 < NQR) qf = qr[d0]; else qf = *reinterpret_cast<const bf16x8*>(qrl + (d0 - NQR) * 1024);
        p0 = __builtin_amdgcn_mfma_f32_32x32x16_bf16(b0, qf, p0, 0, 0, 0);
        p1 = __builtin_amdgcn_mfma_f32_32x32x16_bf16(b1, qf, p1, 0, 0, 0); }
}
template <int NDQ, int NQR, int GS = 2>
__device__ __forceinline__ void qkt4(f32x16& p0, f32x16& p1, const char* Ks, const char* Krs, const bf16x8* qr, const char* qrl, int r32, int hi) {
    if constexpr (GS == 0) qkt4_seq<NDQ, NQR>(p0, p1, Ks, Krs, qr, qrl, r32, hi);
    else {
        static_assert(GS == 0 || NDQ % (GS ? GS : 1) == 0, "k-steps per group");
        constexpr int GS1 = GS ? GS : 1;
        p0 = f32x16{}; p1 = f32x16{};
        bf16x8 ka[2 * GS1], qa[GS1], kb[2 * GS1], qb[GS1];
        qk_reads<0, GS1, NQR>(Ks, Krs, qrl, r32, hi, ka, qa);
        QkChain<0, GS1, NDQ, NQR>::run(p0, p1, Ks, Krs, qr, qrl, r32, hi, ka, qa, kb, qb);
    }
}
template <int D0, int NDV, int GS, int NQR> struct PvChainQ {
    static __device__ __forceinline__ void run(f32x16* o, int vb, bf16x8 pa0, bf16x8 pa1, bf16x8 pa2, bf16x8 pa3, s16x4 (&cur)[8], s16x4 (&nxt)[8],
                                               const char* Ks, const char* Krs, const char* qrl, int r32, int hi, bf16x8 (&ka)[2 * GS], bf16x8 (&qa)[GS]) {
        if constexpr (D0 + 1 < NDV) { pv_reads4<D0 + 1, NDV>(vb, nxt); asm volatile("s_waitcnt lgkmcnt(8)" ::: "memory"); }
        else { qk_reads<0, GS, NQR>(Ks, Krs, qrl, r32, hi, ka, qa); lgkm_wait<2 * GS + (0 >= NQR ? 1 : 0) + ((GS > 1 && 1 >= NQR) ? 1 : 0)>(); }
        SBAR(); pv_mma(o[D0], cur, pa0, pa1, pa2, pa3);
        if constexpr (D0 + 1 < NDV) PvChainQ<D0 + 1, NDV, GS, NQR>::run(o, vb, pa0, pa1, pa2, pa3, nxt, cur, Ks, Krs, qrl, r32, hi, ka, qa);
    }
};
template <int NDQ, int NQR, int NDV, int GS>
__device__ __forceinline__ void pvqk4(f32x16* o, int vb, bf16x8 pa0, bf16x8 pa1, bf16x8 pa2, bf16x8 pa3, f32x16& p0, f32x16& p1, const char* Ks, const char* Krs, const bf16x8* qr, const char* qrl, int r32, int hi) {
    if constexpr (GS == 0 || NDV > 8) { pv_pipe4<NDV>(o, vb, pa0, pa1, pa2, pa3); qkt4<NDQ, NQR, GS>(p0, p1, Ks, Krs, qr, qrl, r32, hi); }
    else {
        constexpr int GS1 = GS ? GS : 1;
        s16x4 ta[8], tb[8]; bf16x8 ka[2 * GS1], qa[GS1], kb[2 * GS1], qb[GS1];
        pv_reads4<0, NDV>(vb, ta);
        PvChainQ<0, NDV, GS1, NQR>::run(o, vb, pa0, pa1, pa2, pa3, ta, tb, Ks, Krs, qrl, r32, hi, ka, qa);
        p0 = f32x16{}; p1 = f32x16{};
        QkChain<0, GS1, NDQ, NQR>::run(p0, p1, Ks, Krs, qr, qrl, r32, hi, ka, qa, kb, qb);
    }
}
template <int NDQ, int NQR, int NDV>
__device__ __forceinline__ void attn_body4(int wv, const bf16* __restrict__ Qb, int ldq, const bf16* __restrict__ Kn, int ldk, const bf16* __restrict__ Kr,
                                           const bf16* __restrict__ V, int ldv, bf16* __restrict__ Ob, int ocol,
                                           int cbase, int lbase, int nct, int NT, float C, float thr, char* lds,
                                           int comb = 0, float lam = 0.f, float post = 0.f, const float* subg = nullptr) {
    static_assert(NQR <= 8 && NQR <= NDQ, "query fragments: NQR in registers, NDQ - NQR in the wave's LDS words");
    constexpr int SHMV = NDV * 4096, TPR = NDV * 4, RPP = 512 / TPR, NP = 64 / RPP, OFF_WS = 2 * SHMV + SHM_K + (NDQ > 8 ? SHM_KR : 0), QLB = (NDQ - NQR) * 1024;
    const int tid = tid_fresh(wv), wid = tid >> 6, lane = tid & 63, r32 = lane & 31, hi = lane >> 5;
    const bool lead = wid < 4;
    char* V_lds = lds; char* K_lds = lds + 2 * SHMV; char* Kr_lds = lds + 2 * SHMV + SHM_K;
    float* wsf = (float*)(lds + OFF_WS) + wid * 64; float* li_l = wsf; float* al_l = wsf + 32;
    float m_reg = -1e30f, l_reg = 0; f32x16 o[NDV]; bf16x8 qr[NQR];
#pragma unroll
    for (int d = 0; d < NDV; ++d) o[d] = f32x16{};
    const bf16* Qw = Qb + (size_t)(wid * 32 + r32) * ldq + hi * 8;
#pragma unroll
    for (int d0 = 0; d0 < NQR; ++d0) qr[d0] = *reinterpret_cast<const bf16x8*>(Qw + d0 * 16);
    char* qrl = lds + OFF_WS + 2048 + wid * QLB + lane * 16;
    if constexpr (NDQ > NQR) {
#pragma unroll
        for (int d0 = NQR; d0 < NDQ; ++d0) *reinterpret_cast<bf16x8*>(qrl + (d0 - NQR) * 1024) = *reinterpret_cast<const bf16x8*>(Qw + d0 * 16);
        asm volatile("s_waitcnt lgkmcnt(0)" ::: "memory");
    }
    const int ksr = tid >> 4, ksc = (tid & 15) * 8;
    const int vsr = tid / TPR, vsc = (tid % TPR) * 8;
    const int rr = tid >> 3, rc = (tid & 7) * 8;
    const int vb0 = (int)(uintptr_t)V_lds + v_rd_base(lane);
    bf16x8 svs[NP], sks0, sks1, skr;
#define KROW4(j) ((j) < nct ? cbase + (j) * KVBLK : lbase + ((j) - nct) * KVBLK)
#define SLOAD4(j) do { const int k0_ = KROW4(j); _Pragma("unroll") for (int p_ = 0; p_ < NP; ++p_) svs[p_] = *reinterpret_cast<const bf16x8*>(&V[(size_t)(k0_ + vsr + RPP * p_) * ldv + vsc]); \
    sks0 = *reinterpret_cast<const bf16x8*>(&Kn[(size_t)(k0_ + ksr) * ldk + ksc]); sks1 = *reinterpret_cast<const bf16x8*>(&Kn[(size_t)(k0_ + 32 + ksr) * ldk + ksc]); \
    if constexpr (NDQ > 8) skr = *reinterpret_cast<const bf16x8*>(&Kr[(size_t)(k0_ + rr) * 64 + rc]); } while (0)
#define SWRITE4(b) do { _Pragma("unroll") for (int p_ = 0; p_ < NP; ++p_) *(bf16x8*)(V_lds + (b) * SHMV + v_st4<NDV>(vsr + RPP * p_, vsc)) = svs[p_]; const int kc = ksc * 2; \
    *(bf16x8*)(K_lds + KSWZ(ksr, kc)) = sks0; *(bf16x8*)(K_lds + KSWZ(32 + ksr, kc)) = sks1; \
    if constexpr (NDQ > 8) *(bf16x8*)(Kr_lds + KRSWZ(rr, rc * 2)) = skr; } while (0)
#define RESC4(a) do { if (__any((a) < 1.f)) { if (hi == 0) al_l[r32] = (a); asm volatile("s_waitcnt lgkmcnt(0)" ::: "memory"); \
    _Pragma("unroll") for (int d = 0; d < NDV; ++d) _Pragma("unroll") for (int r = 0; r < 16; ++r) o[d][r] *= al_l[crow(r, hi)]; } } while (0)
    f32x16 S0, S1; float alpha = 1.f; bf16x8 pa0, pa1, pa2, pa3;
    SLOAD4(0); asm volatile("s_waitcnt vmcnt(0)" ::: "memory"); SWRITE4(0); __syncthreads();
    if (1 < NT) SLOAD4(1);
    SBAR(); qkt4<NDQ, NQR, (NDV >= 8 ? 0 : 2)>(S0, S1, K_lds, Kr_lds, qr, qrl, r32, hi); SBAR();
    if (lead) { softmax_tile(S0, S1, m_reg, l_reg, alpha, C, thr, pa0, pa1, pa2, pa3); }
    __syncthreads(); asm volatile("s_waitcnt vmcnt(0)" ::: "memory"); if (1 < NT) SWRITE4(1); __syncthreads();
    for (int j = 1; j < NT; ++j) {
        const int b = j & 1;
        if (j + 1 < NT) SLOAD4(j + 1);
        const char* Kb = K_lds; const char* Krb = Kr_lds; const int vbp = vb0 + (b ^ 1) * SHMV;
        if (lead) {
            SBAR(); pvqk4<NDQ, NQR, NDV, (NDV >= 8 ? 0 : 2)>(o, vbp, pa0, pa1, pa2, pa3, S0, S1, Kb, Krb, qr, qrl, r32, hi); SBAR();
            softmax_tile(S0, S1, m_reg, l_reg, alpha, C, thr, pa0, pa1, pa2, pa3); RESC4(alpha); SBAR();
        } else {
            SBAR(); softmax_tile(S0, S1, m_reg, l_reg, alpha, C, thr, pa0, pa1, pa2, pa3); RESC4(alpha); SBAR();
            pvqk4<NDQ, NQR, NDV, (NDV >= 8 ? 0 : 2)>(o, vbp, pa0, pa1, pa2, pa3, S0, S1, Kb, Krb, qr, qrl, r32, hi); SBAR();
        }
        __syncthreads(); asm volatile("s_waitcnt vmcnt(0)" ::: "memory"); if (j + 1 < NT) SWRITE4(b ^ 1); __syncthreads();
    }
    if (!lead) { softmax_tile(S0, S1, m_reg, l_reg, alpha, C, thr, pa0, pa1, pa2, pa3); RESC4(alpha); }
    SBAR(); pv_pipe4<NDV>(o, vb0 + ((NT - 1) & 1) * SHMV, pa0, pa1, pa2, pa3);
    if (hi == 0) li_l[r32] = l_reg; asm volatile("s_waitcnt lgkmcnt(0)" ::: "memory");
    float rli[16];
#pragma unroll
    for (int r = 0; r < 16; ++r) rli[r] = __builtin_amdgcn_rcpf(li_l[crow(r, hi)]);
    __syncthreads();
    { constexpr int OP = NDV * 64 + 16, CPR = NDV * 4;
      char* ost = lds + wid * (32 * OP);
#pragma unroll
      for (int r = 0; r < 16; ++r) { const int orow = crow(r, hi);
#pragma unroll
          for (int d0 = 0; d0 < NDV; ++d0) *(bf16*)(ost + orow * OP + (d0 * 32 + r32) * 2) = f2bf(o[d0][r] * rli[r]); }
      asm volatile("s_waitcnt lgkmcnt(0)" ::: "memory");
      const int tid_e = tid_fresh(wv), wid_e = tid_e >> 6, lane_e = tid_e & 63, hi_e = lane_e >> 5;
      bool plain = true;
      if constexpr (NDV == 8) {
          if (comb) { plain = false;
              const int chunk = lane_e & 31;
              const f32x4 g0 = ((const f32x4*)subg)[2 * chunk], g1 = ((const f32x4*)subg)[2 * chunk + 1];
              u64 q0[16][2];
#pragma unroll
              for (int i = 0; i < 16; ++i) { const u64* p = (const u64*)(Ob + pg8::aimg_off(wid_e * 32 + 2 * i + hi_e, ocol + chunk * 8));
                  q0[i][0] = __hip_atomic_load(p, __ATOMIC_RELAXED, __HIP_MEMORY_SCOPE_AGENT); q0[i][1] = __hip_atomic_load(p + 1, __ATOMIC_RELAXED, __HIP_MEMORY_SCOPE_AGENT); }
#pragma unroll
              for (int i = 0; i < 16; ++i) {
                  const u32x4 v1 = *(const u32x4*)(ost + (2 * i + hi_e) * OP + chunk * 16);
                  const unsigned a0 = (unsigned)q0[i][0], a1 = (unsigned)(q0[i][0] >> 32), a2 = (unsigned)q0[i][1], a3 = (unsigned)(q0[i][1] >> 32);
                  f32x4 d0, d1;
                  d0[0] = __uint_as_float(a0 << 16) - lam * __uint_as_float(v1.x << 16); d0[1] = __uint_as_float(a0 & 0xffff0000u) - lam * __uint_as_float(v1.x & 0xffff0000u);
                  d0[2] = __uint_as_float(a1 << 16) - lam * __uint_as_float(v1.y << 16); d0[3] = __uint_as_float(a1 & 0xffff0000u) - lam * __uint_as_float(v1.y & 0xffff0000u);
                  d1[0] = __uint_as_float(a2 << 16) - lam * __uint_as_float(v1.z << 16); d1[1] = __uint_as_float(a2 & 0xffff0000u) - lam * __uint_as_float(v1.z & 0xffff0000u);
                  d1[2] = __uint_as_float(a3 << 16) - lam * __uint_as_float(v1.w << 16); d1[3] = __uint_as_float(a3 & 0xffff0000u) - lam * __uint_as_float(v1.w & 0xffff0000u);
                  const float ss = half_sum(((d0[0] * d0[0] + d0[1] * d0[1]) + (d0[2] * d0[2] + d0[3] * d0[3])) + ((d1[0] * d1[0] + d1[1] * d1[1]) + (d1[2] * d1[2] + d1[3] * d1[3])));
                  const float rstd = post / sqrtf(ss * (1.0f / 256.0f) + 1e-5f);
                  const f32x4 y0 = d0 * rstd * g0, y1 = d1 * rstd * g1;
                  u32x4 w; w.x = cvt_pk_bf16(y0[0], y0[1]); w.y = cvt_pk_bf16(y0[2], y0[3]); w.z = cvt_pk_bf16(y1[0], y1[1]); w.w = cvt_pk_bf16(y1[2], y1[3]);
                  *(u32x4*)(Ob + pg8::aimg_off(wid_e * 32 + 2 * i + hi_e, ocol + chunk * 8)) = w;
              }
          }
      }
      if (plain) {
#pragma unroll
      for (int i = 0; i < 32 * CPR / 64; ++i) { const int idx = lane_e + 64 * i, row = idx / CPR, chunk = idx % CPR;
          const u32x4 v = *(const u32x4*)(ost + row * OP + chunk * 16);
          *(u32x4*)(Ob + pg8::aimg_off(wid_e * 32 + row, ocol + chunk * 8)) = v; } } }
    __syncthreads();
#undef KROW4
#undef SLOAD4
#undef SWRITE4
#undef RESC4
}
__device__ __forceinline__ void attn_mla(int wv, const bf16* Q, const bf16* KV, const bf16* KR, bf16* AO, int need_ctx) {
    extern __shared__ __attribute__((aligned(16))) unsigned char lds[];
    const int G = gridDim.x, bx = blockIdx.x; const int vcu = (G % 8 == 0) ? (bx % 8) * (G / 8) + bx / 8 : bx;
    const float scale = 0.07216878364870322f;
    const float C = scale * 1.4426950408889634f, thr = 8.f / scale;
    const int NUL = NBATCH * 16 * 8, NUC = need_ctx ? NBATCH * 16 : 0;
    for (int u = vcu; u < NUL + NUC; u += G) {
        int b, h, qrow, nct, NT;
        if (u < NUL) { const int bh = u >> 3, qb = u & 7; b = bh >> 4; h = bh & 15; qrow = TC + b * SEQ + qb * 256; nct = 4; NT = 36; }
        else { const int bh = u - NUL; b = bh >> 4; h = bh & 15; qrow = b * CTXL; nct = 4; NT = 4; }
        attn_body4<12, 8, 4>(wv, Q + (size_t)qrow * 3072 + h * 192, 3072, KV + h * 256, 4096, KR, KV + h * 256 + 128, 4096, AO + (size_t)qrow * DM, h * 128,
                      b * CTXL, TC + b * SEQ, nct, NT, C, thr, (char*)lds);
    }
}
__device__ __forceinline__ void attn_diff(int wv, const bf16* QKV, bf16* OD, const float* lambdas, const float* subg, float lambda_init, int need_ctx) {
    extern __shared__ __attribute__((aligned(16))) unsigned char lds[];
    const int G = gridDim.x, bx = blockIdx.x; const int vcu = (G % 8 == 0) ? (bx % 8) * (G / 8) + bx / 8 : bx;
    const float scale = 0.08838834764831845f;
    const float C = scale * 1.4426950408889634f, thr = 8.f / scale;
    const int lane = tid_fresh(wv) & 63;
    const float la = lambdas[lane] * lambdas[128 + lane] + lambdas[64 + lane] * lambdas[192 + lane];
    const float lb = lambdas[256 + lane] * lambdas[384 + lane] + lambdas[320 + lane] * lambdas[448 + lane];
    const float lam = expf(wave_sum(la)) - expf(wave_sum(lb)) + lambda_init;
    const float post = 1.0f - lambda_init;
    const int NUL = NBATCH * 8 * 8, NUC = need_ctx ? NBATCH * 8 : 0;
    for (int u = vcu; u < NUL + NUC; u += G) {
        int b, h, qrow, NT;
        if (u < NUL) { const int bh = u >> 3, qb = u & 7; b = bh >> 3; h = bh & 7; qrow = TC + b * SEQ + qb * 256; NT = 36; }
        else { const int bh = u - NUL; b = bh >> 3; h = bh & 7; qrow = b * CTXL; NT = 4; }
        for (int c = 0; c < 2; ++c) {
            const int vh = 2 * h + c;
            attn_body4<8, 1, 8>(wv, QKV + (size_t)qrow * 6144 + vh * 128, 6144, QKV + 2048 + vh * 128, 6144, nullptr, QKV + 4096 + h * 256, 6144,
                                OD + (size_t)qrow * DM, h * 256, b * CTXL, TC + b * SEQ, 4, NT, C, thr, (char*)lds, c, lam, post, subg);
        }
    }
}

__device__ __forceinline__ void final_norm_phase(int wv, float* out, const float* gvec) {
    const int tid_ = tid_fresh(wv); const int lane = tid_ & 63, wave = tid_ >> 6; const int gw = blockIdx.x * NWAVES + wave, NGW = gridDim.x * NWAVES;
    f32x4 g[8];
#pragma unroll
    for (int j = 0; j < 8; ++j) g[j] = ((const f32x4*)gvec + lane)[64 * j];
    f32x4 nv[8], nv2[8];
    if (gw < TL) { const int r2 = gw + NGW < TL ? gw + NGW : gw; const f32x4* a = (const f32x4*)(out + (size_t)gw * DM) + lane; const f32x4* c = (const f32x4*)(out + (size_t)r2 * DM) + lane;
#pragma unroll
        for (int j = 0; j < 8; ++j) { nv[j] = a[64 * j]; nv2[j] = c[64 * j]; } }
    for (int row = gw; row < TL; row += 2 * NGW) {
        const int row2 = row + NGW < TL ? row + NGW : row;
        f32x4* xr = (f32x4*)(out + (size_t)row * DM) + lane; f32x4* xr2 = (f32x4*)(out + (size_t)row2 * DM) + lane;
        f32x4 v[8], v2[8]; float s = 0.f, s2 = 0.f;
#pragma unroll
        for (int j = 0; j < 8; ++j) { v[j] = nv[j]; v2[j] = nv2[j]; }
        { const int rn = row + 2 * NGW; if (rn < TL) { const int rn2 = rn + NGW < TL ? rn + NGW : rn; const f32x4* a = (const f32x4*)(out + (size_t)rn * DM) + lane; const f32x4* c = (const f32x4*)(out + (size_t)rn2 * DM) + lane;
#pragma unroll
            for (int j = 0; j < 8; ++j) { nv[j] = a[64 * j]; nv2[j] = c[64 * j]; } } }
#pragma unroll
        for (int j = 0; j < 8; ++j) { s += (v[j].x * v[j].x + v[j].y * v[j].y) + (v[j].z * v[j].z + v[j].w * v[j].w); s2 += (v2[j].x * v2[j].x + v2[j].y * v2[j].y) + (v2[j].z * v2[j].z + v2[j].w * v2[j].w); }
        const float rstd = 1.0f / sqrtf(wave_sum(s) * (1.0f / DM) + 1e-6f), rstd2 = 1.0f / sqrtf(wave_sum(s2) * (1.0f / DM) + 1e-6f);
#pragma unroll
        for (int j = 0; j < 8; ++j) { xr[64 * j] = v[j] * rstd * g[j]; if (row2 != row) xr2[64 * j] = v2[j] * rstd2 * g[j]; }
    }
}
__device__ __forceinline__ void gate_load(const bf16* Z, int tb_lo, int NTB_C, int un, int trow, int chunk, u32x4 (&vm)[3], u32x4 (&vc)[3], u32x4 (&vp)[3]) {
    const int tb = tb_lo + un / 32, c0 = (un % 32) * 64;
    int t0, L, rbase;
    if (tb < NTB_C) { t0 = (tb & 3) * 64; L = CTXL; rbase = (tb >> 2) * CTXL; } else { const int q = tb - NTB_C; t0 = (q & 31) * 64; L = SEQ; rbase = TC + (q >> 5) * SEQ; }
    const int t = t0 + trow;
#pragma unroll
    for (int p = 1; p < 3; ++p) {
        const bf16* zp = Z + (size_t)(rbase + t) * 6144 + p * DM + c0 + chunk * 8;
        vm[p] = (u32x4){0u, 0u, 0u, 0u}; vp[p] = (u32x4){0u, 0u, 0u, 0u};
        vc[p] = *(const u32x4*)zp;
        if (t > 0) vm[p] = *(const u32x4*)(zp - 6144);
        if (t < L - 1) vp[p] = *(const u32x4*)(zp + 6144);
    }
}
__device__ __forceinline__ void hy_gate_phase(int wv, const bf16* Z, bf16* Gt, const float* cw, const float* cb, int need_ctx) {
    extern __shared__ __attribute__((aligned(16))) unsigned char lds[];
    LAS bf16* gl0 = (LAS bf16*)lds;
    const int tid = tid_fresh(wv), trow = tid >> 3, chunk = tid & 7;
    const int NTB_C = NBATCH * (CTXL / 64), NTB = NTB_C + NBATCH * (SEQ / 64);
    int par = 0;
    const int tb_lo = need_ctx ? 0 : NTB_C;
    const int NU = (NTB - tb_lo) * 32;
    int cblk_cur = -1;
    float w0[3][8], w1[3][8], w2[3][8], bb[3][8];
    u32x4 nm[3], nc[3], np[3];
    if ((int)blockIdx.x < NU) gate_load(Z, tb_lo, NTB_C, blockIdx.x, trow, chunk, nm, nc, np);
    for (int u = blockIdx.x; u < NU; u += gridDim.x) {
        const int tb = tb_lo + u / 32, cblk = u % 32, c0 = cblk * 64;
        if (cblk != cblk_cur) {
            cblk_cur = cblk;
#pragma unroll
            for (int p = 1; p < 3; ++p) { const int col = p * DM + c0 + chunk * 8;
#pragma unroll
                for (int h = 0; h < 2; ++h) { const f32x4 a0 = *(const f32x4*)(cw + col + 4 * h), a1 = *(const f32x4*)(cw + 6144 + col + 4 * h), a2 = *(const f32x4*)(cw + 2 * 6144 + col + 4 * h), a3 = *(const f32x4*)(cb + col + 4 * h);
#pragma unroll
                    for (int e = 0; e < 4; ++e) { w0[p][4 * h + e] = a0[e]; w1[p][4 * h + e] = a1[e]; w2[p][4 * h + e] = a2[e]; bb[p][4 * h + e] = a3[e]; } } }
        }
        int b, t0, L, rbase; bf16* gdst;
        if (tb < NTB_C) { b = tb >> 2; t0 = (tb & 3) * 64; L = CTXL; rbase = b * CTXL; gdst = Gt + (size_t)DM * NBATCH * SEQ + ((size_t)c0 * NBATCH + b) * CTXL + t0; }
        else { const int q = tb - NTB_C; b = q >> 5; t0 = (q & 31) * 64; L = SEQ; rbase = TC + b * SEQ; gdst = Gt + ((size_t)c0 * NBATCH + b) * SEQ + t0; }
        const int t = t0 + trow; const size_t row = (size_t)(rbase + t);
        u32x4 cm[3], cc[3], cp[3];
#pragma unroll
        for (int p = 1; p < 3; ++p) { cm[p] = nm[p]; cc[p] = nc[p]; cp[p] = np[p]; }
        { const int un = u + gridDim.x; if (un < NU) gate_load(Z, tb_lo, NTB_C, un, trow, chunk, nm, nc, np); }
        float zc[3][8];
#pragma unroll
        for (int p = 1; p < 3; ++p) {
            const u32x4 vm = cm[p], v0 = cc[p], vp = cp[p];
#pragma unroll
            for (int e = 0; e < 4; ++e) {
                const float m0 = __uint_as_float(vm[e] << 16), m1 = __uint_as_float(vm[e] & 0xffff0000u);
                const float c0f = __uint_as_float(v0[e] << 16), c1f = __uint_as_float(v0[e] & 0xffff0000u);
                const float p0 = __uint_as_float(vp[e] << 16), p1 = __uint_as_float(vp[e] & 0xffff0000u);
                zc[p][2 * e] = w0[p][2 * e] * m0 + w1[p][2 * e] * c0f + w2[p][2 * e] * p0 + bb[p][2 * e];
                zc[p][2 * e + 1] = w0[p][2 * e + 1] * m1 + w1[p][2 * e + 1] * c1f + w2[p][2 * e + 1] * p1 + bb[p][2 * e + 1];
            }
        }
        LAS bf16* gl = gl0 + par * (64 * 72); par ^= 1;
#pragma unroll
        for (int e = 0; e < 8; ++e) gl[(chunk * 8 + e) * 72 + trow] = f2bf(zc[2][e] * zc[1][e]);
        __syncthreads();
        { const int c = tid >> 3;
          const u32x4 v = *(const LAS u32x4*)(gl + c * 72 + chunk * 8);
          *(u32x4*)(gdst + (size_t)c * NBATCH * L + chunk * 8) = v; }
    }
    __syncthreads();
}
__device__ __forceinline__ void mul_load(const bf16* Yt, const bf16* Z, int tb_lo, int NTB_C, int un, int tid, u32x4& yv, u32x4& xm, u32x4& xc, u32x4& xp) {
    const int trow = tid >> 3, chunk = tid & 7, c = tid >> 3;
    const int tb = tb_lo + un / 32, c0 = (un % 32) * 64;
    int b, t0, L, rbase; const bf16* src;
    if (tb < NTB_C) { b = tb >> 2; t0 = (tb & 3) * 64; L = CTXL; rbase = b * CTXL; src = Yt + (size_t)DM * NBATCH * SEQ + ((size_t)c0 * NBATCH + b) * CTXL + t0; }
    else { const int q = tb - NTB_C; b = q >> 5; t0 = (q & 31) * 64; L = SEQ; rbase = TC + b * SEQ; src = Yt + ((size_t)c0 * NBATCH + b) * SEQ + t0; }
    yv = *(const u32x4*)(src + (size_t)c * NBATCH * L + chunk * 8);
    const int t = t0 + trow; const bf16* zp = Z + (size_t)(rbase + t) * 6144 + c0 + chunk * 8;
    xm = (u32x4){0u, 0u, 0u, 0u}; xp = (u32x4){0u, 0u, 0u, 0u};
    xc = *(const u32x4*)zp;
    if (t > 0) xm = *(const u32x4*)(zp - 6144);
    if (t < L - 1) xp = *(const u32x4*)(zp + 6144);
}
__device__ __forceinline__ void hy_mul_phase(int wv, const bf16* Yt, const bf16* Z, bf16* Y, const float* cw, const float* cb, int need_ctx) {
    extern __shared__ __attribute__((aligned(16))) unsigned char lds[];
    LAS bf16* gl0 = (LAS bf16*)lds;
    const int tid = tid_fresh(wv), trow = tid >> 3, chunk = tid & 7;
    const int NTB_C = NBATCH * (CTXL / 64), NTB = NTB_C + NBATCH * (SEQ / 64);
    const int tb_lo = need_ctx ? 0 : NTB_C;
    const int NU = (NTB - tb_lo) * 32;
    int cblk_cur = -1, par = 0;
    float w0[8], w1[8], w2[8], bb[8];
    u32x4 ny, nm, nc, np;
    if ((int)blockIdx.x < NU) mul_load(Yt, Z, tb_lo, NTB_C, blockIdx.x, tid, ny, nm, nc, np);
    for (int u = blockIdx.x; u < NU; u += gridDim.x) {
        const int tb = tb_lo + u / 32, cblk = u % 32, c0 = cblk * 64;
        if (cblk != cblk_cur) {
            cblk_cur = cblk;
            const int col = c0 + chunk * 8;
#pragma unroll
            for (int h = 0; h < 2; ++h) { const f32x4 a0 = *(const f32x4*)(cw + col + 4 * h), a1 = *(const f32x4*)(cw + 6144 + col + 4 * h), a2 = *(const f32x4*)(cw + 2 * 6144 + col + 4 * h), a3 = *(const f32x4*)(cb + col + 4 * h);
#pragma unroll
                for (int e = 0; e < 4; ++e) { w0[4 * h + e] = a0[e]; w1[4 * h + e] = a1[e]; w2[4 * h + e] = a2[e]; bb[4 * h + e] = a3[e]; } }
        }
        int t0, rbase;
        if (tb < NTB_C) { t0 = (tb & 3) * 64; rbase = (tb >> 2) * CTXL; } else { const int q = tb - NTB_C; t0 = (q & 31) * 64; rbase = TC + (q >> 5) * SEQ; }
        const u32x4 yv = ny, vm = nm, v0 = nc, vp = np;
        { const int un = u + gridDim.x; if (un < NU) mul_load(Yt, Z, tb_lo, NTB_C, un, tid, ny, nm, nc, np); }
        LAS bf16* gl = gl0 + par * (64 * 72); par ^= 1;
        { const int c = tid >> 3; *(LAS u32x4*)(gl + c * 72 + chunk * 8) = yv; }
        const size_t oy = (size_t)((rbase + t0 + trow) & ~255) * DM + pg8::aimg_off((t0 + trow) & 255, c0 + chunk * 8);
        float x0[8];
#pragma unroll
        for (int e = 0; e < 4; ++e) {
            const float m0 = __uint_as_float(vm[e] << 16), m1 = __uint_as_float(vm[e] & 0xffff0000u);
            const float c0f = __uint_as_float(v0[e] << 16), c1f = __uint_as_float(v0[e] & 0xffff0000u);
            const float p0 = __uint_as_float(vp[e] << 16), p1 = __uint_as_float(vp[e] & 0xffff0000u);
            x0[2 * e] = w0[2 * e] * m0 + w1[2 * e] * c0f + w2[2 * e] * p0 + bb[2 * e];
            x0[2 * e + 1] = w0[2 * e + 1] * m1 + w1[2 * e + 1] * c1f + w2[2 * e + 1] * p1 + bb[2 * e + 1];
        }
        __syncthreads();
        float y[8];
#pragma unroll
        for (int e = 0; e < 8; ++e) y[e] = bf2f(gl[(chunk * 8 + e) * 72 + trow]);
        u32x4 w;
        w.x = cvt_pk_bf16(y[0] * x0[0], y[1] * x0[1]); w.y = cvt_pk_bf16(y[2] * x0[2], y[3] * x0[3]);
        w.z = cvt_pk_bf16(y[4] * x0[4], y[5] * x0[5]); w.w = cvt_pk_bf16(y[6] * x0[6], y[7] * x0[7]);
        *(u32x4*)(Y + oy) = w;
    }
    __syncthreads();
}
template <int LF>
__device__ __forceinline__ void conv_wave(LAS const unsigned char* gl, LAS const unsigned char* rkl, int tw0, float fb, bf16* ydst  , int lane) {
    constexpr int GP = (LF + 8) * 2, RP = (2 * LF + 16) * 2, NS = LF / 32;
    const int i = lane & 15, q = lane >> 4, a = i & 7, ih = i - a;
    f32x4 acc[16];
#pragma unroll
    for (int m = 0; m < 16; ++m) acc[m] = (f32x4){0.f, 0.f, 0.f, 0.f};
    const LAS unsigned char* gb = gl + i * GP + q * 16;
    const LAS unsigned char* rb = rkl + a * RP + (LF - tw0 - 240 + 8 * q - ih) * 2;
    bf16x8 F[16];
#pragma unroll
    for (int m = 0; m < 16; ++m) F[m] = *(const LAS bf16x8*)(rb + (15 - m) * 32);
    bf16x8 B = *(const LAS bf16x8*)gb;
    for (int n8 = 0; n8 < NS; n8 += 8) {
#pragma unroll
        for (int r = 0; r < 8; ++r) {
            const int n = n8 + r;
            const bf16x8 nA0 = *(const LAS bf16x8*)(rb + (15 + 2 * n + 2) * 32), nA1 = *(const LAS bf16x8*)(rb + (15 + 2 * n + 1) * 32);
            const bf16x8 nB = *(const LAS bf16x8*)(gb + (n + 1) * 64);
#pragma unroll
            for (int m = 0; m < 16; ++m) acc[m] = __builtin_amdgcn_mfma_f32_16x16x32_bf16(F[(m - 2 * r) & 15], B, acc[m], 0, 0, 0);
            F[(14 - 2 * r) & 15] = nA0; F[(15 - 2 * r) & 15] = nA1; B = nB;
        }
    }
#pragma unroll
    for (int m = 0; m < 16; ++m) {
        const int t = tw0 + 16 * m + 4 * q;
        const u32x2 gw = *(const LAS u32x2*)(gl + i * GP + t * 2);
        const float g0 = __uint_as_float(gw.x << 16), g1 = __uint_as_float(gw.x & 0xffff0000u), g2 = __uint_as_float(gw.y << 16), g3 = __uint_as_float(gw.y & 0xffff0000u);
        u32x2 w; w.x = cvt_pk_bf16(acc[m][0] + g0 * fb, acc[m][1] + g1 * fb); w.y = cvt_pk_bf16(acc[m][2] + g2 * fb, acc[m][3] + g3 * fb);
        *(u32x2*)(ydst + (size_t)i * LF + t) = w;
    }
}
__device__ __forceinline__ void rk_scatter(LAS unsigned char* rkl, int RP, int t, u32x4 w) {
#pragma unroll
    for (int a = 0; a < 8; ++a) {
        LAS unsigned char* p = rkl + a * RP + (8 * t + a) * 2;
        if ((a & 1) == 0) { *(LAS unsigned*)(p) = w.x; *(LAS unsigned*)(p + 4) = w.y; *(LAS unsigned*)(p + 8) = w.z; *(LAS unsigned*)(p + 12) = w.w; }
        else { *(LAS bf16*)(p) = (bf16)(w.x & 0xffffu);
            *(LAS unsigned*)(p + 2) = __builtin_amdgcn_alignbit(w.y, w.x, 16); *(LAS unsigned*)(p + 6) = __builtin_amdgcn_alignbit(w.z, w.y, 16); *(LAS unsigned*)(p + 10) = __builtin_amdgcn_alignbit(w.w, w.z, 16);
            *(LAS bf16*)(p + 14) = (bf16)(w.w >> 16); }
    }
}
__device__ __forceinline__ void hy_conv_phase(int wv, const bf16* Gt, bf16* Yt, const bf16* KFL, const bf16* KFC, const float* fbias, int need_ctx) {
    extern __shared__ __attribute__((aligned(16))) unsigned char lds[];
    const int tid = tid_fresh(wv), lane = tid & 63, wave = tid >> 6;
    {
        constexpr int LF = SEQ, GP = (LF + 8) * 2, RP = (2 * LF + 16) * 2;
        LAS unsigned char* gl = (LAS unsigned char*)lds; LAS unsigned char* rkl = gl + 16 * GP;
        u32x4 gq[8], rq;
        int c = blockIdx.x;
        if (c < DM) {
            const bf16* gsrc = Gt + (size_t)c * NBATCH * LF;
#pragma unroll
            for (int i = 0; i < 8; ++i) gq[i] = *(const u32x4*)(gsrc + (size_t)(tid + i * NTHREADS) * 8);
            rq = *(const u32x4*)(KFL + (size_t)c * (2 * LF) + 8 * tid);
        }
        for (; c < DM; c += gridDim.x) {
#pragma unroll
            for (int i = 0; i < 8; ++i) { const int idx = tid + i * NTHREADS; const int b = idx / (LF / 8), s8 = idx % (LF / 8); *(LAS u32x4*)(gl + b * GP + s8 * 16) = gq[i]; }
            rk_scatter(rkl, RP, tid, rq);
            __syncthreads();
            const int cn = c + gridDim.x;
            if (cn < DM) {
                const bf16* gsrc = Gt + (size_t)cn * NBATCH * LF;
#pragma unroll
                for (int i = 0; i < 8; ++i) gq[i] = *(const u32x4*)(gsrc + (size_t)(tid + i * NTHREADS) * 8);
                rq = *(const u32x4*)(KFL + (size_t)cn * (2 * LF) + 8 * tid);
            }
            conv_wave<LF>(gl, rkl, wave * 256, fbias[c], Yt + (size_t)c * NBATCH * LF, lane);
            __syncthreads();
        }
    }
    if (need_ctx) {
        constexpr int LF = CTXL, GP = (LF + 8) * 2, RP = (2 * LF + 16) * 2;
        LAS unsigned char* gl = (LAS unsigned char*)lds + wave * (16 * GP + 8 * RP); LAS unsigned char* rkl = gl + 16 * GP;
        const bf16* GtC = Gt + (size_t)DM * NBATCH * SEQ; bf16* YtC = Yt + (size_t)DM * NBATCH * SEQ;
        for (int c = blockIdx.x * NWAVES + wave; c < DM; c += gridDim.x * NWAVES) {
            const bf16* gsrc = GtC + (size_t)c * NBATCH * LF;
            u32x4 gq[8];
#pragma unroll
            for (int i = 0; i < 8; ++i) gq[i] = *(const u32x4*)(gsrc + (size_t)(lane + i * 64) * 8);
            const u32x4 rq = *(const u32x4*)(KFC + (size_t)c * (2 * LF) + 8 * lane);
#pragma unroll
            for (int i = 0; i < 8; ++i) { const int idx = lane + i * 64; const int b = idx / (LF / 8), s8 = idx % (LF / 8); *(LAS u32x4*)(gl + b * GP + s8 * 16) = gq[i]; }
            rk_scatter(rkl, RP, lane, rq);
            LDS_WAIT(); asm volatile("" ::: "memory");
            conv_wave<LF>(gl, rkl, 0, fbias[c], YtC + (size_t)c * NBATCH * LF, lane);
            LDS_WAIT(); asm volatile("" ::: "memory");
        }
        __syncthreads();
    }
}

struct Args { const float* in[36]; float* out; unsigned char* ws; int ph_lo, ph_hi; };
__device__ __forceinline__ int rope_src(int j, int R) { const int hR = R >> 1; const int axis = j / hR, jj = j % hR; return axis * hR + (jj & 1) * (R >> 2) + (jj >> 1); }
__device__ __forceinline__ void ti_load(const float* W, int Nsrc, int scol0, int k0, int lane, f32x4 (&v)[8]) {
    const int n4 = lane & 7, kr = lane >> 3;
    const float* wp = W + (size_t)(k0 + kr) * Nsrc + scol0 + 4 * n4;
#pragma unroll
    for (int i = 0; i < 8; ++i) v[i] = *(const f32x4*)(wp + (size_t)(8 * i) * Nsrc);
}
__device__ __forceinline__ void ti_store(int K, bf16* WT, int n0, int k0, LAS float* scr, int lane) {
    LDS_WAIT(); asm volatile("" ::: "memory");
    const int c = lane & 7;
#pragma unroll
    for (int j = 0; j < 4; ++j) { const int n = (lane >> 3) + 8 * j; const LAS float* s = scr + (8 * c) * 33 + n;
        u32x4 o; o.x = cvt_pk_bf16(s[0 * 33], s[1 * 33]); o.y = cvt_pk_bf16(s[2 * 33], s[3 * 33]); o.z = cvt_pk_bf16(s[4 * 33], s[5 * 33]); o.w = cvt_pk_bf16(s[6 * 33], s[7 * 33]);
        *(u32x4*)((char*)WT + pg8::wimg_off(n0 + n, k0 + 8 * c, K)) = o; }
    LDS_WAIT(); asm volatile("" ::: "memory");
}
__device__ __forceinline__ void ti_finish(const f32x4 (&v)[8], int K, bf16* WT, int n0, int k0, LAS float* scr, int lane) {
    const int n4 = lane & 7, kr = lane >> 3;
#pragma unroll
    for (int i = 0; i < 8; ++i) { LAS float* d = scr + (kr + 8 * i) * 33 + 4 * n4; d[0] = v[i].x; d[1] = v[i].y; d[2] = v[i].z; d[3] = v[i].w; }
    ti_store(K, WT, n0, k0, scr, lane);
}
__device__ __forceinline__ void transpose_item_slow(const float* W, int K, int Nsrc, int scol0, int pm, bf16* WT, int n0, int k0, LAS float* scr, int lane) {
    int sc = -1;
    if (scol0 >= 0) { const int j = lane & 31;
        if (pm == 1) { const int blk = scol0 & ~63, w = (scol0 & 63) + j; sc = blk + rope_src(w, 64); }
        else if (pm == 2) { const int blk = scol0 & ~127, w = (scol0 & 127) + j; sc = blk + rope_src(w, 128); }
        else sc = scol0 + j; }
#pragma unroll 8
    for (int i = 0; i < 32; ++i) { const int kk = 2 * i + (lane >> 5); scr[kk * 33 + (lane & 31)] = sc >= 0 ? W[(size_t)(k0 + kk) * Nsrc + sc] : 0.f; }
    ti_store(K, WT, n0, k0, scr, lane);
}
struct CJ { int src, src2; unsigned src_off, src2_off; int K, Nsrc, Ndst, kind; unsigned long long dst; };
#define WJ(src, soff, K, Ns, Nd, kind, dst) { src, 13, (unsigned)(soff), 0u, K, Ns, Nd, kind, (unsigned long long)(dst) }
__device__ const CJ g_jobs[20] = {
    { 10, 13, 0u, 0u, DM, 768, 1536, 1, WS_W + W_DQKV },
    { 10, 13, (unsigned)(DM * 768), (unsigned)(DM * 576), DM, 768, 1536, 1, WS_W + W_DQKV + (unsigned long long)1536 * DM * 2 },
    WJ(12, 0, 768, 3072, 3072, 2, WS_W + W_UQ), WJ(12, 768 * 3072, 768, 3072, 3072, 2, WS_W + W_UQ + (unsigned long long)3072 * 768 * 2),
    WJ(15, 0, 512, 4096, 4096, 0, WS_W + W_UKV), WJ(15, 512 * 4096, 512, 4096, 4096, 0, WS_W + W_UKV + (unsigned long long)4096 * 512 * 2),
    WJ(16, 0, DM, DM, DM, 0, WS_W + W_WOA), WJ(16, DM * DM, DM, DM, DM, 0, WS_W + W_WOA + (unsigned long long)DM * DM * 2),
    WJ(17, 0, DM, 6144, 6144, 0, WS_W + W_HYIN), WJ(30, 0, DM, DM, DM, 0, WS_W + W_HYOUT),
    WJ(32, 0, DM, 6144, 6144, 3, WS_W + W_DFQKV), WJ(35, 0, DM, DM, DM, 0, WS_W + W_DFWO),
    WJ(7, 0, DM, DFF, DFF, 0, WS_W + W_W1), WJ(7, 1 * DM * DFF, DM, DFF, DFF, 0, WS_W + W_W1 + (unsigned long long)1 * DFF * DM * 2),
    WJ(7, 2 * DM * DFF, DM, DFF, DFF, 0, WS_W + W_W1 + (unsigned long long)2 * DFF * DM * 2), WJ(7, 3 * DM * DFF, DM, DFF, DFF, 0, WS_W + W_W1 + (unsigned long long)3 * DFF * DM * 2),
    WJ(8, 0, DFF, DM, DM, 0, WS_W + W_W2), WJ(8, 1 * DM * DFF, DFF, DM, DM, 0, WS_W + W_W2 + (unsigned long long)1 * DFF * DM * 2),
    WJ(8, 2 * DM * DFF, DFF, DM, DM, 0, WS_W + W_W2 + (unsigned long long)2 * DFF * DM * 2), WJ(8, 3 * DM * DFF, DFF, DM, DM, 0, WS_W + W_W2 + (unsigned long long)3 * DFF * DM * 2),
};
#undef WJ

__device__ __forceinline__ void mod_unit(int wv, unsigned char* ws, int uu) {
    extern __shared__ __attribute__((aligned(16))) unsigned char lds[];
    const int tid = tid_fresh(wv), lane = tid & 63, wave = tid >> 6;
    LAS float* S = (LAS float*)lds;
    const float* cin = in_ptr(1); const float* cctx = in_ptr(3);
    const int layer = uu / 48, cb = (uu % 48) * 256;
    const char* Wl = (const char*)(in_ptr(4) + (size_t)layer * DM * NMOD + cb);
    const unsigned voff = (unsigned)lane * 16u;
    f32x4 acc[17];
#pragma unroll
    for (int b = 0; b < 17; ++b) acc[b] = (f32x4){0.f, 0.f, 0.f, 0.f};
    for (int kc = 0; kc < 2; ++kc) {
        for (int idx = tid; idx < 17 * 1024; idx += NTHREADS) { const int bi = idx >> 10, k = idx & 1023; const float x = bi < 16 ? cin[bi * DM + kc * 1024 + k] : cctx[kc * 1024 + k];
            S[k * 20 + bi] = x * __builtin_amdgcn_rcpf(1.0f + __builtin_amdgcn_exp2f(-1.4426950408889634f * x)); }
        __syncthreads();
        const int kbeg = wave * 128;
#pragma unroll 1
        for (int k8 = kbeg; k8 < kbeg + 128; k8 += 16) {
            f32x4 wq[16];
#pragma unroll
            for (int j = 0; j < 16; ++j) wq[j] = *(const f32x4*)(Wl + (size_t)(kc * 1024 + k8 + j) * (NMOD * 4) + voff);
#pragma unroll
            for (int j = 0; j < 16; ++j) { const int k = k8 + j; const f32x4 w = wq[j];
                const LAS f32x4* sp = (const LAS f32x4*)(S + k * 20);
                const f32x4 s0 = sp[0], s1 = sp[1], s2 = sp[2], s3 = sp[3]; const float s16 = S[k * 20 + 16];
                acc[0] += w * s0.x; acc[1] += w * s0.y; acc[2] += w * s0.z; acc[3] += w * s0.w;
                acc[4] += w * s1.x; acc[5] += w * s1.y; acc[6] += w * s1.z; acc[7] += w * s1.w;
                acc[8] += w * s2.x; acc[9] += w * s2.y; acc[10] += w * s2.z; acc[11] += w * s2.w;
                acc[12] += w * s3.x; acc[13] += w * s3.y; acc[14] += w * s3.z; acc[15] += w * s3.w;
                acc[16] += w * s16; }
        }
        __syncthreads();
    }
    LAS float* P = (LAS float*)lds;
#pragma unroll
    for (int b = 0; b < 17; ++b) *(LAS f32x4*)(P + (wave * 17 + b) * 256 + 4 * lane) = acc[b];
    __syncthreads();
    float* MOD = (float*)(ws + WS_MOD);
    const float* ab = in_ptr(5) + (size_t)layer * NMOD + cb;
    for (int idx = tid; idx < 17 * 256; idx += NTHREADS) { const int bi = idx >> 8, col = idx & 255; float s = ab[col];
#pragma unroll
        for (int w = 0; w < 8; ++w) s += P[(w * 17 + bi) * 256 + col];
        MOD[((size_t)layer * 17 + bi) * NMOD + cb + col] = s; }
    __syncthreads();
}
__device__ __forceinline__ void filter_unit(int wv, unsigned char* ws, int u) {
    extern __shared__ __attribute__((aligned(16))) unsigned char lds[];
    const int tid = tid_fresh(wv);
    LAS float* feats = (LAS float*)lds;
    LAS float* hA = feats + 16 * 36;
    LAS float* hB = hA + 16 * 64;
    LAS float* hT = hB + 16 * 64;
    const float *w1 = in_ptr(21), *b1 = in_ptr(22), *w2 = in_ptr(23), *b2 = in_ptr(24), *w3 = in_ptr(25), *b3 = in_ptr(26), *fr = in_ptr(27), *wout = in_ptr(28);
    const int Lf = u < 128 ? SEQ : CTXL; const int i0 = (u < 128 ? u : u - 128) * 16;
    bf16* KF = u < 128 ? (bf16*)(ws + WS_KFL) : (bf16*)(ws + WS_KFC);
    const float invLm1 = 1.0f / (float)(Lf - 1), invL = 1.0f / (float)Lf;
    for (int idx = tid; idx < 16 * 33; idx += NTHREADS) { const int r = idx / 33, e = idx % 33; const int i = i0 + r;
        float v;
        if (e == 0) v = (float)i * invLm1;
        else { const int j = (e - 1) & 15; const float f = 1e-4f + (float)j * ((15.0f - 1e-4f) / 15.0f);
            float turns = f * ((float)i * invL); turns -= floorf(turns);
            v = (e <= 16) ? __builtin_amdgcn_cosf(turns) : -__builtin_amdgcn_sinf(turns); }
        feats[r * 36 + e] = v; }
    __syncthreads();
    for (int idx = tid; idx < 16 * 64; idx += NTHREADS) { const int r = idx >> 6, o = idx & 63; float s = b1[o];
        for (int e = 0; e < 33; ++e) s += feats[r * 36 + e] * w1[e * 64 + o];
        hA[r * 64 + o] = sinf(fr[o] * s); }
    __syncthreads();
    for (int idx = tid; idx < 16 * 64; idx += NTHREADS) { const int r = idx >> 6, o = idx & 63; float s = b2[o];
        for (int e = 0; e < 64; ++e) s += hA[r * 64 + e] * w2[e * 64 + o];
        hB[r * 64 + o] = sinf(fr[64 + o] * s); }
    __syncthreads();
    for (int idx = tid; idx < 16 * 64; idx += NTHREADS) { const int r = idx >> 6, o = idx & 63; float s = b3[o];
        for (int e = 0; e < 64; ++e) s += hB[r * 64 + e] * w3[e * 64 + o];
        hT[o * 16 + r] = sinf(fr[128 + o] * s); }
    __syncthreads();
#pragma unroll 1
    for (int pp = 0; pp < 4; ++pp) {
        const int pass = pp >> 1, rh = (pp & 1) * 8;
        const int j0 = pass * 2048 + tid * 4;
        f32x4 acc[8];
#pragma unroll
        for (int r = 0; r < 8; ++r) acc[r] = (f32x4){0.f, 0.f, 0.f, 0.f};
#pragma unroll 1
        for (int k16 = 0; k16 < 64; k16 += 16) {
            f32x4 wq[16];
#pragma unroll
            for (int j = 0; j < 16; ++j) wq[j] = *(const f32x4*)(wout + (size_t)(k16 + j) * 4096 + j0);
#pragma unroll
            for (int j = 0; j < 16; ++j) { const f32x4 w = wq[j];
                const LAS f32x4* hp = (const LAS f32x4*)(hT + (k16 + j) * 16 + rh);
                const f32x4 h0 = hp[0], h1 = hp[1];
                acc[0] += w * h0.x; acc[1] += w * h0.y; acc[2] += w * h0.z; acc[3] += w * h0.w;
                acc[4] += w * h1.x; acc[5] += w * h1.y; acc[6] += w * h1.z; acc[7] += w * h1.w; }
        }
#pragma unroll
        for (int e = 0; e < 4; ++e) {
            const int c = (j0 & 2047) + e;
            const float dl2 = -1.4426950408889634f * (3.0701134573253945f + (float)c * (12.280453829301578f / 2047.0f));
            bf16* kf = KF + (size_t)c * (2 * Lf);
#pragma unroll
            for (int r = 0; r < 8; ++r) { const int i = i0 + rh + r; const float tt = (float)i * invLm1;
                const float v = acc[r][e] * __builtin_amdgcn_exp2f(tt * dl2);
                if (pass == 0) kf[Lf - i] = f2bf(v);
                else { if (i > 0) kf[Lf + i] = f2bf(v); else kf[0] = 0; } }
        }
    }
    __syncthreads();
}
__device__ __forceinline__ void prologue_phase(int wv, unsigned char* ws) {
    extern __shared__ __attribute__((aligned(16))) unsigned char lds[];
    if (gridDim.x >= 256) {
        for (int rep = 0; rep < (PROBE_DUP == 10 ? 2 : 1); ++rep) {
        if (blockIdx.x < 192) mod_unit(wv, ws, blockIdx.x);
        else { for (int u = blockIdx.x - 192; u < 144; u += gridDim.x - 192) filter_unit(wv, ws, u); }
        }
    } else {
        for (int uu = blockIdx.x; uu < 192; uu += gridDim.x) mod_unit(wv, ws, uu);
        for (int u = blockIdx.x; u < 144; u += gridDim.x) filter_unit(wv, ws, u);
    }
    const int tid = tid_fresh(wv), lane = tid & 63, wave = tid >> 6;
    {
        f32x2* tabA = (f32x2*)(ws + WS_TAB); f32x2* tabD = (f32x2*)(ws + WS_TAB + 16384);
        for (int idx = blockIdx.x * NTHREADS + tid; idx < 64 * 16 + 64 * 32; idx += gridDim.x * NTHREADS) {
            int p, f; float nf; f32x2* dst;
            if (idx < 1024) { p = idx >> 4; f = idx & 15; nf = 1.0f / 16.0f; dst = tabA + idx; } else { const int q = idx - 1024; p = q >> 5; f = q & 31; nf = 1.0f / 32.0f; dst = tabD + q; }
            const float invf = __builtin_amdgcn_exp2f(-(float)f * nf * 13.287712379549449f);
            float turns = (float)p * invf * 0.15915494309189535f; turns -= floorf(turns);
            *dst = (f32x2){__builtin_amdgcn_cosf(turns), __builtin_amdgcn_sinf(turns)};
        }
    }
    {
        LAS float* scr = (LAS float*)(lds + wave * 16384);
        LAS unsigned* tick = (LAS unsigned*)(lds + 8 * 16384);
        unsigned* ctr = (unsigned*)(ws + WS_CTL) + 2048;
        constexpr int JP[21] = {0, 1536, 3072, 4224, 5376, 6400, 7424, 9472, 11520, 17664, 19712, 25856, 27904, 36096, 44288, 52480, 60672, 68864, 77056, 85248, 93440};
        constexpr int total = JP[20];
        f32x4 pv[8]; int pn0 = 0, pk0 = 0, pK = 0; bf16* pdst = nullptr; bool have = false;
        for (;;) {
            __syncthreads();
            if (tid == 0) *tick = __hip_atomic_fetch_add(ctr, 64u, __ATOMIC_RELAXED, __HIP_MEMORY_SCOPE_AGENT);
            __syncthreads();
            const int base = __builtin_amdgcn_readfirstlane((int)*tick);
            if (base >= total) break;
            const int it0 = base + wv * 8; if (it0 >= total) continue;
            int jb = 0, joff = 0;
#pragma unroll
            for (int k = 1; k < 20; ++k) { const bool ge = it0 >= JP[k]; jb += ge ? 1 : 0; joff = ge ? JP[k] : joff; }
            const CJ J = g_jobs[jb];
            const float* src = in_ptr(J.src) + J.src_off; const float* src2 = in_ptr(J.src2) + J.src2_off;
            bf16* dst = (bf16*)(ws + J.dst);
            const int K = J.K, nnb = J.Ndst / 32;
            const int itj = it0 - joff; const int nb0 = itj % nnb, kb = itj / nnb; const int k0 = kb * 64;
#pragma unroll 1
            for (int q = 0; q < 8; ++q) {
                const int n0 = (nb0 + q) * 32;
                const float* W = src; int ns = J.Nsrc, scol0 = n0, pm = 0;
                if (J.kind == 1) {
                    if (n0 < 768) { } else if (n0 < 1344) { W = src2; ns = 576; scol0 = n0 - 768; pm = (scol0 >= 512) ? 1 : 0; } else scol0 = -1;
                } else if (J.kind == 2) { pm = ((n0 % 192) >= 128) ? 1 : 0; }
                else if (J.kind == 3) { pm = (n0 < 4096) ? 2 : 0; }
                if (pm == 0 && scol0 >= 0) {
                    f32x4 cv[8]; ti_load(W, ns, scol0, k0, lane, cv);
                    if (have) ti_finish(pv, pK, pdst, pn0, pk0, scr, lane);
#pragma unroll
                    for (int i = 0; i < 8; ++i) pv[i] = cv[i];
                    pn0 = n0; pk0 = k0; pK = K; pdst = dst; have = true;
                } else {
                    if (have) { ti_finish(pv, pK, pdst, pn0, pk0, scr, lane); have = false; }
                    transpose_item_slow(W, K, ns, scol0, pm, dst, n0, k0, scr, lane);
                }
            }
        }
        if (have) ti_finish(pv, pK, pdst, pn0, pk0, scr, lane);
    }
    __syncthreads();
}

struct SJ { int layer, chunk; unsigned long long w; int N; unsigned off; };
__device__ const SJ g_shw[8] = {
    {0, 0, WS_W + W_DQKV, 1536, 0u}, {0, 3, WS_W + W_W1, 8192, 26112u}, {1, 0, WS_W + W_HYIN, 6144, 165376u}, {1, 3, WS_W + W_W1 + (unsigned long long)1 * DFF * DM * 2, 8192, 269824u},
    {2, 0, WS_W + W_DFQKV, 6144, 409088u}, {2, 3, WS_W + W_W1 + (unsigned long long)2 * DFF * DM * 2, 8192, 513536u},
    {3, 0, WS_W + W_DQKV + (unsigned long long)1536 * DM * 2, 1536, 652800u}, {3, 3, WS_W + W_W1 + (unsigned long long)3 * DFF * DM * 2, 8192, 678912u} };
__device__ __forceinline__ void prep_phase(int wv, unsigned char* ws) {
    extern __shared__ __attribute__((aligned(16))) unsigned char lds[];
    const int tid = tid_fresh(wv), lane = tid & 63, wave = tid >> 6; const int gw = blockIdx.x * NWAVES + wave, NGW = gridDim.x * NWAVES;
    const float* MOD = (const float*)(ws + WS_MOD);
    {
        float* GC = (float*)(ws + WS_GC); const float* ng = in_ptr(6);
        for (int idx = blockIdx.x * NTHREADS + tid; idx < 8 * 17 * 512; idx += gridDim.x * NTHREADS) { const int c4 = idx & 511, r = idx >> 9, bi = r % 17, lw = r / 17, l = lw >> 1, w = lw & 1;
            const f32x4 g = ((const f32x4*)(ng + (size_t)lw * DM))[c4], sc = ((const f32x4*)(MOD + ((size_t)l * 17 + bi) * NMOD + (w ? 4 : 1) * DM))[c4];
            ((f32x4*)(GC + ((size_t)lw * 17 + bi) * DM))[c4] = g * (sc + 1.0f); }
    }
    {
        bf16* XG = (bf16*)(ws + WS_R + R_XGB); u64* SSQ0 = (u64*)(ws + WS_SSQ);
        const float* ng = in_ptr(6); const float* xs = in_ptr(0); const float* cs = in_ptr(2);
        const f32x4* gp = (const f32x4*)ng + lane;
        f32x4 vn[8], vm[8];
        if (gw < TT) { const f32x4* xr = (const f32x4*)(gw < TC ? cs + (size_t)gw * DM : xs + (size_t)(gw - TC) * DM) + lane;
#pragma unroll
            for (int j = 0; j < 8; ++j) vn[j] = xr[64 * j]; }
        if (gw + NGW < TT) { const int r1 = gw + NGW; const f32x4* xr = (const f32x4*)(r1 < TC ? cs + (size_t)r1 * DM : xs + (size_t)(r1 - TC) * DM) + lane;
#pragma unroll
            for (int j = 0; j < 8; ++j) vm[j] = xr[64 * j]; }
        for (int row = gw; row < TT; row += NGW) {
            const int bi = bi_of(row);
            const f32x4* scp = (const f32x4*)(MOD + (size_t)bi * NMOD + DM) + lane;
            f32x4 v[8]; float sq = 0.f;
#pragma unroll
            for (int j = 0; j < 8; ++j) { v[j] = vn[j]; vn[j] = vm[j]; }
            { const int rn = row + 2 * NGW; if (rn < TT) { const f32x4* xr = (const f32x4*)(rn < TC ? cs + (size_t)rn * DM : xs + (size_t)(rn - TC) * DM) + lane;
#pragma unroll
                for (int j = 0; j < 8; ++j) vm[j] = xr[64 * j]; } }
#pragma unroll
            for (int j = 0; j < 8; ++j) sq += (v[j].x * v[j].x + v[j].y * v[j].y) + (v[j].z * v[j].z + v[j].w * v[j].w);
            sq = wave_sum(sq);
            if (lane == 0) SSQ0[row] = (u64)__float2ll_rn(sq * 1048576.0f);
            bf16* xo = XG + (size_t)(row >> 8) * (BM * DM) + pg8::aimg_off(row & 255, 4 * lane);
#pragma unroll
            for (int j = 0; j < 8; ++j) { const f32x4 y = v[j] * gp[64 * j] * (scp[64 * j] + 1.0f);
                u32x2 w; w.x = cvt_pk_bf16(y.x, y.y); w.y = cvt_pk_bf16(y.z, y.w); *(u32x2*)(xo + (size_t)(4 * j) * (BM * 64)) = w; }
        }
    }
    {
        LAS float* S = (LAS float*)lds;
        const bool dealt = gridDim.x == 256;
        int ci_lo = 0, ci_hi = 8, wrank = gw, wcount = NGW;
        if (dealt) { const int bx = blockIdx.x; const int ci = bx < 8 ? 0 : bx < 52 ? 1 : bx < 85 ? 2 : bx < 128 ? 3 : bx < 161 ? 4 : bx < 205 ? 5 : bx < 213 ? 6 : 7;
            const int base = ci == 0 ? 0 : ci == 1 ? 8 : ci == 2 ? 52 : ci == 3 ? 85 : ci == 4 ? 128 : ci == 5 ? 161 : ci == 6 ? 205 : 213;
            const int cnt = (ci == 0 || ci == 6) ? 8 : (ci == 2 || ci == 4) ? 33 : (ci == 1 || ci == 5) ? 44 : 43;
            ci_lo = ci; ci_hi = ci + 1; wrank = (bx - base) * NWAVES + wave; wcount = cnt * NWAVES; }
#pragma unroll 1
        for (int ci = ci_lo; ci < ci_hi; ++ci) {
            const SJ J = g_shw[ci];
            __syncthreads();
            for (int idx = tid; idx < 17 * 512; idx += NTHREADS) { const int bi = idx >> 9, c4 = idx & 511;
                ((LAS f32x4*)S)[idx] = ((const f32x4*)(MOD + ((size_t)J.layer * 17 + bi) * NMOD + J.chunk * DM))[c4]; }
            __syncthreads();
            const bf16* W = (const bf16*)(ws + J.w); float* out = (float*)(ws + WS_SHW) + J.off;
#pragma unroll 1
            for (int n = wrank * 2; n < J.N; n += wcount * 2) {
                float a0[17], a1[17];
#pragma unroll
                for (int b = 0; b < 17; ++b) { a0[b] = 0.f; a1[b] = 0.f; }
#pragma unroll 1
                for (int j = 0; j < 4; ++j) {
                    const u32x4 p0 = *(const u32x4*)((const char*)W + pg8::wimg_off(n, 8 * lane + 512 * j, DM)), p1 = *(const u32x4*)((const char*)W + pg8::wimg_off(n + 1, 8 * lane + 512 * j, DM));
                    float x0[8], x1[8];
#pragma unroll
                    for (int e = 0; e < 4; ++e) { x0[2 * e] = __uint_as_float(p0[e] << 16); x0[2 * e + 1] = __uint_as_float(p0[e] & 0xffff0000u); x1[2 * e] = __uint_as_float(p1[e] << 16); x1[2 * e + 1] = __uint_as_float(p1[e] & 0xffff0000u); }
#pragma unroll
                    for (int b = 0; b < 17; ++b) { const LAS f32x4* sp = (const LAS f32x4*)(S + b * DM + 8 * lane + 512 * j); const f32x4 s0 = sp[0], s1 = sp[1];
                        a0[b] += (x0[0] * s0.x + x0[1] * s0.y) + (x0[2] * s0.z + x0[3] * s0.w) + (x0[4] * s1.x + x0[5] * s1.y) + (x0[6] * s1.z + x0[7] * s1.w);
                        a1[b] += (x1[0] * s0.x + x1[1] * s0.y) + (x1[2] * s0.z + x1[3] * s0.w) + (x1[4] * s1.x + x1[5] * s1.y) + (x1[6] * s1.z + x1[7] * s1.w);
                        if ((b & 3) == 3) asm volatile("" ::: "memory"); }
                }
#pragma unroll
                for (int b = 0; b < 17; ++b) { const float r0 = wave_sum(a0[b]), r1 = wave_sum(a1[b]); if (lane == 0) { out[(size_t)b * J.N + n] = r0; out[(size_t)b * J.N + n + 1] = r1; } }
            }
        }
        __syncthreads();
    }
}

__global__ void __launch_bounds__(NTHREADS, 2) mega_fwd(Args args) {
    extern __shared__ __attribute__((aligned(16))) unsigned char lds[];
    volatile LAS unsigned* MISC = (volatile LAS unsigned*)((LAS unsigned char*)lds + MISC_OFF);
    if (threadIdx.x < 32) MISC[threadIdx.x] = 0u;
    __syncthreads();
    unsigned char* const ws0 = args.ws;
    const int wv = __builtin_amdgcn_readfirstlane(threadIdx.x >> 6);
    XcdBarrier bar = xcd_barrier_post((unsigned*)(ws0 + WS_CTL) + CW_BAR, MISC + 8);
    const int lo = args.ph_lo, hi = args.ph_hi;
    int ph = 0;
#define IN_PH() (lo <= ph && ph < hi)
#define END_PH() do { if (lo <= ph && ph + 1 < hi) xcd_barrier(bar.bar, bar.x, bar.st, tid_fresh(wv) == 0, gridDim.x); ++ph; } while (0)
#define WSP(T, off) ((T*)(ws + (off)))

    if (IN_PH()) { for (int rep = 0; rep < (PROBE_DUP == 4 ? 2 : 1); ++rep) prologue_phase(wv, fresh(ws0)); }
    END_PH();
    if (IN_PH()) prep_phase(wv, fresh(ws0));
    END_PH();

#define RP(T, off) ((T*)(ws + WS_R + (off)))
#define SSQP(nid) ((u64*)(ws + WS_SSQ) + (size_t)(nid) * TT)
#define SHWP(ci) ((const float*)(ws + WS_SHW) + g_shw[ci].off)
#define GCP(lw) ((const float*)(ws + WS_GC) + (size_t)(lw) * 17 * DM)
    for (int layer = 0; layer < 4; ++layer) {
        const int need_ctx = layer < 3;
        const int row_lo = need_ctx ? 0 : TC;
        const int Mres = TT - row_lo;
        const size_t modoff = WS_MOD + (size_t)layer * 17 * NMOD * 4;
        const Pre nopre{nullptr, nullptr, 0, 0, 0.f};
        constexpr float INV_D = 1.0f / (1048576.0f * DM);
        if (layer == 0 || layer == 3) {
            const int j = layer == 0 ? 0 : 1;
            constexpr size_t O_DQKV = 144 * MiB, O_Q = 144 * MiB, O_CQN = 0, O_CKVN = 54 * MiB, O_KR = 360 * MiB, O_KV = 365 * MiB, O_AO = 0;
            if (IN_PH()) { unsigned char* ws = fresh(ws0); gemm_dqkv(wv, RP(bf16, R_XGB), WSP(bf16, WS_W + W_DQKV) + (size_t)j * 1536 * DM, RP(bf16, O_CQN), RP(bf16, O_CKVN), RP(bf16, O_KR), in_ptr(11) + j * 768, in_ptr(14) + j * 512, WSP(f32x2, WS_TAB),
                                                               Pre{SSQP(2 * layer), SHWP(layer == 0 ? 0 : 6), 1536, 0, INV_D}, SSQP(9 + 2 * j), SSQP(10 + 2 * j)); }
            END_PH();
            if (IN_PH()) {
                { unsigned char* ws = fresh(ws0); gemm_rope(wv, RP(bf16, O_CQN) + (size_t)row_lo * 768, WSP(bf16, WS_W + W_UQ) + (size_t)j * 3072 * 768, Mres, 3072, 768, RP(bf16, O_Q) + (size_t)row_lo * 3072, 3072, WSP(f32x2, WS_TAB), 1, Pre{SSQP(9 + 2 * j), nullptr, 0, row_lo, 1.0f / (1048576.0f * 768.0f)}, 1); }
                { unsigned char* ws = fresh(ws0); gemm_bf16(wv, RP(bf16, O_CKVN), WSP(bf16, WS_W + W_UKV) + (size_t)j * 4096 * 512, TT, 4096, 512, RP(bf16, O_KV), 4096, nullptr, 0, Pre{SSQP(10 + 2 * j), nullptr, 0, 0, 1.0f / (1048576.0f * 512.0f)}, 0, 1); }
            }
            END_PH();
            if (IN_PH()) { for (int rep = 0; rep < (PROBE_DUP == 2 ? 2 : 1); ++rep) { unsigned char* ws = fresh(ws0); attn_mla(wv, RP(bf16, O_Q), RP(bf16, O_KV), RP(bf16, O_KR), RP(bf16, O_AO), need_ctx); } }
            END_PH();
            if (IN_PH()) { unsigned char* ws = fresh(ws0); gemm_resid(wv, RP(bf16, O_AO) + (size_t)row_lo * DM, WSP(bf16, WS_W + W_WOA) + (size_t)j * DM * DM, Mres, DM, DM, WSP(bf16, WS_H), nullptr, WSP(float, modoff) + 2 * DM, row_lo, RP(bf16, R_XGB), GCP(layer * 2 + 1), SSQP(2 * layer + 1), layer == 0 ? in_ptr(0) : nullptr, layer == 0 ? in_ptr(2) : nullptr, nullptr, 1); }
            END_PH();
        } else if (layer == 1) {
            constexpr size_t O_Z = 0, O_YT = 432 * MiB, O_GT = 600 * MiB;
            bf16* const Yp = (bf16*)(fresh(ws0) + WS_H + 144 * MiB);
            if (IN_PH()) { unsigned char* ws = fresh(ws0); gemm_bf16(wv, RP(bf16, R_XGB), WSP(bf16, WS_W + W_HYIN), TT, 6144, DM, RP(bf16, O_Z), 6144, in_ptr(18), 0, Pre{SSQP(2), SHWP(2), 6144, 0, INV_D}, 0, 1); }
            END_PH();
            if (IN_PH()) { for (int rep = 0; rep < (PROBE_DUP == 6 ? 2 : 1); ++rep) { unsigned char* ws = fresh(ws0); hy_gate_phase(wv, RP(bf16, O_Z), RP(bf16, O_GT), in_ptr(19), in_ptr(20), need_ctx); } }
            END_PH();
            if (IN_PH()) { for (int rep = 0; rep < (PROBE_DUP == 6 ? 2 : 1); ++rep) { unsigned char* ws = fresh(ws0); hy_conv_phase(wv, RP(bf16, O_GT), RP(bf16, O_YT), WSP(bf16, WS_KFL), WSP(bf16, WS_KFC), in_ptr(29), need_ctx); } }
            END_PH();
            if (IN_PH()) { for (int rep = 0; rep < (PROBE_DUP == 6 ? 2 : 1); ++rep) { unsigned char* ws = fresh(ws0); hy_mul_phase(wv, RP(bf16, O_YT), RP(bf16, O_Z), Yp, in_ptr(19), in_ptr(20), need_ctx); } }
            END_PH();
            if (IN_PH()) { unsigned char* ws = fresh(ws0); gemm_resid(wv, Yp + (size_t)row_lo * DM, WSP(bf16, WS_W + W_HYOUT), Mres, DM, DM, WSP(bf16, WS_H), in_ptr(31), WSP(float, modoff) + 2 * DM, row_lo, RP(bf16, R_XGB), GCP(layer * 2 + 1), SSQP(2 * layer + 1), nullptr, nullptr, nullptr, 1); }
            END_PH();
        } else {
            constexpr size_t O_QKV = 0, O_OD0 = 432 * MiB;
            const float lambda_init = 0.8f - 0.6f * 0.5488116360940264f;
            if (IN_PH()) { unsigned char* ws = fresh(ws0); gemm_rope(wv, RP(bf16, R_XGB), WSP(bf16, WS_W + W_DFQKV), TT, 6144, DM, RP(bf16, O_QKV), 6144, WSP(f32x2, WS_TAB + 16384), 2, Pre{SSQP(4), SHWP(4), 6144, 0, INV_D}, 1); }
            END_PH();
            if (IN_PH()) { for (int rep = 0; rep < (PROBE_DUP == 3 ? 2 : 1); ++rep) { unsigned char* ws = fresh(ws0); attn_diff(wv, RP(bf16, O_QKV), RP(bf16, O_OD0), in_ptr(33), in_ptr(34), lambda_init, need_ctx); } }
            END_PH();
            if (IN_PH()) { unsigned char* ws = fresh(ws0); gemm_resid(wv, RP(bf16, O_OD0) + (size_t)row_lo * DM, WSP(bf16, WS_W + W_DFWO), Mres, DM, DM, WSP(bf16, WS_H), nullptr, WSP(float, modoff) + 2 * DM, row_lo, RP(bf16, R_XGB), GCP(layer * 2 + 1), SSQP(2 * layer + 1), layer == 0 ? in_ptr(0) : nullptr, layer == 0 ? in_ptr(2) : nullptr, nullptr, 1); }
            END_PH();
        }
        if (IN_PH()) { for (int rep = 0; rep < (PROBE_DUP == 1 ? 2 : 1); ++rep) { unsigned char* ws = fresh(ws0); gemm_bf16(wv, RP(bf16, R_XGB) + (size_t)row_lo * DM, WSP(bf16, WS_W + W_W1) + (size_t)layer * DFF * DM, Mres, DFF, DM, RP(bf16, 0) + (size_t)row_lo * DFF, DFF, nullptr, 1, Pre{SSQP(2 * layer + 1), SHWP(2 * layer + 1), DFF, row_lo, INV_D}, 1, 1); } }
        END_PH();
        if (IN_PH() && PROBE_DUP == 9) { unsigned char* ws = fresh(ws0); gemm_bf16(wv, RP(bf16, 0) + (size_t)row_lo * DFF, WSP(bf16, WS_W + W_W2) + (size_t)layer * DM * DFF, Mres, DM, DFF, RP(bf16, R_XGB) + (size_t)row_lo * DM, DM, nullptr, 0, nopre); }
        if (IN_PH()) { unsigned char* ws = fresh(ws0); gemm_resid(wv, RP(bf16, 0) + (size_t)row_lo * DFF, WSP(bf16, WS_W + W_W2) + (size_t)layer * DM * DFF, Mres, DM, DFF, WSP(bf16, WS_H), nullptr, WSP(float, modoff) + 5 * DM, row_lo,
                                                               layer < 3 ? RP(bf16, R_XGB) : nullptr, layer < 3 ? GCP(layer * 2 + 2) : nullptr, layer < 3 ? SSQP(2 * layer + 2) : nullptr, nullptr, nullptr, layer == 3 ? args.out : nullptr, 1); }
        END_PH();
    }
    if (IN_PH()) { unsigned char* ws = fresh(ws0); final_norm_phase(wv, args.out, in_ptr(9)); }
}

#ifndef PROBE_DUP
#define PROBE_DUP 0
#endif
#ifndef MK_SPLIT
#define MK_SPLIT 0
#endif
constexpr int N_PHASES = 2 + 4 * 2 + (4 + 5 + 3 + 4) + 1;
extern "C" void kernel_launch(void* const* d_in, const int* in_sizes, int n_in, void* d_out, int out_size, void* d_ws, size_t ws_size, hipStream_t stream) {
    static int grid = 0;
    if (grid == 0) {
        if (n_in != 36 || out_size != TL * DM || ws_size < WS_END) { fprintf(stderr, "kernel_launch: unexpected shapes: n_in %d out %d ws %zu (need %zu)\n", n_in, out_size, ws_size, (size_t)WS_END); grid = -1; return; }
        int dev = 0, cus = 0, per_cu = 0;
        if (hipGetDevice(&dev) != hipSuccess || hipDeviceGetAttribute(&cus, hipDeviceAttributeMultiprocessorCount, dev) != hipSuccess) { grid = -1; return; }
        if (hipFuncSetAttribute((const void*)mega_fwd, hipFuncAttributeMaxDynamicSharedMemorySize, LDS_BYTES) != hipSuccess) { fprintf(stderr, "kernel_launch: hipFuncSetAttribute failed\n"); grid = -1; return; }
        if (hipOccupancyMaxActiveBlocksPerMultiprocessor(&per_cu, (const void*)mega_fwd, NTHREADS, LDS_BYTES) != hipSuccess || per_cu < 1) { fprintf(stderr, "kernel_launch: occupancy query says %d\n", per_cu); (void)hipGetLastError(); }
        grid = cus;
    }
    if (grid < 0) return;
    (void)hipMemsetAsync((char*)d_ws + WS_CTL, 0, CTL_ZERO_BYTES, stream);
    Args a; memset(&a, 0, sizeof(a));
    for (int i = 0; i < 36; ++i) a.in[i] = (const float*)d_in[i];
    a.out = (float*)d_out; a.ws = (unsigned char*)d_ws;
#if MK_SPLIT
    for (int p = 0; p < N_PHASES; ++p) { a.ph_lo = p; a.ph_hi = p + 1; hipLaunchKernelGGL(mega_fwd, dim3(grid), dim3(NTHREADS), LDS_BYTES, stream, a); }
#else
    a.ph_lo = 0; a.ph_hi = N_PHASES;
    hipLaunchKernelGGL(mega_fwd, dim3(grid), dim3(NTHREADS), LDS_BYTES, stream, a);
#endif
    const hipError_t le = hipPeekAtLastError();
    if (le != hipSuccess) fprintf(stderr, "kernel_launch: launch failed: %s\n", hipGetErrorName(le));
}
```
